# Optimizing an MI355X kernel written in HIP

```python
import math
import jax, jax.numpy as jnp
from jax import lax
import numpy as np

D_MODEL = 1024
BATCH = 2
SEQ = 16384
DEPTH = 2
DEC_BATCH = 4
DEC_SEQ = 8192
PAST_LEN = 128

CHUNK = 128
D_A = 512
G_A = 4
GA_DIM = D_A // G_A
D_B = 512
H_B = 4
HB_DIM = D_B // H_B
D_C = 512
G_C = 4
GC_DIM = D_C // G_C
N_BRANCH = 3
D_FF = 2816
ROPE_BASE = 10000.0
LN_EPS = 1e-5
ALPHA = (2.0 * DEPTH) ** 0.25
BETA = (8.0 * DEPTH) ** -0.25
D_IN = N_BRANCH * D_MODEL + 2 * D_A + 4 * D_B + D_C

kernel_name = "hybrid_gmlp_retention_fnet_encoder"


def layer_norm(x, g, b):
    xf = x.astype(jnp.float32)
    mu = jnp.mean(xf, -1, keepdims=True)
    var = jnp.mean(jnp.square(xf - mu), -1, keepdims=True)
    return ((xf - mu) * lax.rsqrt(var + LN_EPS) * g + b).astype(x.dtype)


def swiglu(x, w_gate, w_up, w_down):
    return (jax.nn.silu(x @ w_gate) * (x @ w_up)) @ w_down


def rotary(x):
    L = x.shape[1]
    half = x.shape[-1] // 2
    inv = ROPE_BASE ** (-jnp.arange(half, dtype=jnp.float32) / half)
    ang = jnp.arange(L, dtype=jnp.float32)[:, None] * inv[None, :]
    cos = jnp.cos(ang)[None, :, None, :]
    sin = jnp.sin(ang)[None, :, None, :]
    x1, x2 = x[..., :half], x[..., half:]
    return jnp.concatenate([x1 * cos - x2 * sin, x1 * sin + x2 * cos], -1)


def retention_dir(q, k, v, log_gamma, include_diag):
    idx = jnp.arange(CHUNK)
    idxf = idx.astype(jnp.float32)
    rel = idx[:, None] - idx[None, :]
    mask = (rel >= 0) if include_diag else (rel > 0)
    relf = jnp.where(mask, rel, 0).astype(jnp.float32)
    dmat = jnp.where(mask[None], jnp.exp(relf[None] * log_gamma[:, None, None]), 0.0)
    scores = jnp.einsum('bnihd,bnjhd->bnhij', q, k) * dmat
    intra = jnp.einsum('bnhij,bnjhe->bnihe', scores, v)
    k_dec = k * jnp.exp((CHUNK - 1 - idxf)[:, None] * log_gamma[None, :])[:, :, None]
    kv = jnp.einsum('bnjhd,bnjhe->nbhde', k_dec, v)
    chunk_decay = jnp.exp(CHUNK * log_gamma)[None, :, None, None]

    def step(state, kv_n):
        return chunk_decay * state + kv_n, state

    _, prev = lax.scan(step, jnp.zeros_like(kv[0]), kv)
    q_dec = q * jnp.exp((idxf + 1.0)[:, None] * log_gamma[None, :])[:, :, None]
    cross = jnp.einsum('bnihd,nbhde->bnihe', q_dec, prev)
    return intra + cross


def retention_branch(q, k, v, g, logit_f, logit_b, gn_g, gn_b):
    bsz, L, _ = q.shape
    n = L // CHUNK
    heads = lambda t: t.astype(jnp.float32).reshape(bsz, L, H_B, HB_DIM)
    qh = rotary(heads(q)) * (HB_DIM ** -0.5)
    kh = rotary(heads(k))
    vh = heads(v)
    chunk = lambda t: t.reshape(bsz, n, CHUNK, H_B, HB_DIM)
    flip = lambda t: chunk(t[:, ::-1])
    lg_f = jax.nn.log_sigmoid(logit_f.astype(jnp.float32))
    lg_b = jax.nn.log_sigmoid(logit_b.astype(jnp.float32))
    fwd = retention_dir(chunk(qh), chunk(kh), chunk(vh), lg_f, True)
    bwd = retention_dir(flip(qh), flip(kh), flip(vh), lg_b, False)
    o = fwd.reshape(bsz, L, H_B, HB_DIM) + bwd.reshape(bsz, L, H_B, HB_DIM)[:, ::-1]
    mu = jnp.mean(o, -1, keepdims=True)
    var = jnp.mean(jnp.square(o - mu), -1, keepdims=True)
    o = ((o - mu) * lax.rsqrt(var + LN_EPS)).reshape(bsz, L, D_B) * gn_g + gn_b
    return (jax.nn.silu(g.astype(jnp.float32)) * o).astype(q.dtype)


def sgu_branch(z, ln_g, ln_b, w_s, b_s):
    bsz, L, _ = z.shape
    z = jax.nn.gelu(z)
    u, v = jnp.split(z, 2, axis=-1)
    v = layer_norm(v, ln_g, ln_b).reshape(bsz, L // CHUNK, CHUNK, G_A, GA_DIM)
    v = jnp.einsum('gij,bnjgc->bnigc', w_s, v) + b_s.T[:, :, None]
    return u * v.reshape(bsz, L, D_A)


def fourier_branch(z):
    bsz, L, _ = z.shape
    zf = z.astype(jnp.float32).reshape(bsz, L, G_C, GC_DIM)
    y = jnp.fft.fft2(zf, axes=(1, 3), norm="ortho").real
    return y.reshape(bsz, L, D_C).astype(z.dtype)


def token_mixer(x, w_in, b_in, sgu_ln_g, sgu_ln_b, sgu_w, sgu_b, logit_f, logit_b,
                gn_g, gn_b, w_br_a, w_br_b, w_br_c, w_o):
    h = x @ w_in + b_in
    sizes = (N_BRANCH * D_MODEL, 2 * D_A, D_B, D_B, D_B, D_B, D_C)
    cuts = [int(c) for c in np.cumsum(sizes)[:-1]]
    gates, za, q, k, v, g, zc = jnp.split(h, cuts, axis=-1)
    ya = sgu_branch(za, sgu_ln_g, sgu_ln_b, sgu_w, sgu_b) @ w_br_a
    yb = retention_branch(q, k, v, g, logit_f, logit_b, gn_g, gn_b) @ w_br_b
    yc = fourier_branch(zc) @ w_br_c
    ga, gb, gc = jnp.split(jax.nn.sigmoid(gates), N_BRANCH, axis=-1)
    return (ga * ya + gb * yb + gc * yc) @ w_o


def trunk(x, params):
    (ffn1_w_gate, ffn1_w_up, ffn1_w_down, ln1_g, ln1_b, w_in, b_in, sgu_ln_g, sgu_ln_b,
     sgu_w, sgu_b, ret_logit_fwd, ret_logit_bwd, ret_gn_g, ret_gn_b, w_br_a, w_br_b, w_br_c,
     w_o, ln2_g, ln2_b, ffn2_w_gate, ffn2_w_up, ffn2_w_down, ln3_g, ln3_b) = params
    for l in range(DEPTH):
        x = layer_norm(ALPHA * x + 0.5 * swiglu(x, ffn1_w_gate[l], ffn1_w_up[l], ffn1_w_down[l]),
                       ln1_g[l], ln1_b[l])
        mix = token_mixer(x, w_in[l], b_in[l], sgu_ln_g[l], sgu_ln_b[l], sgu_w[l], sgu_b[l],
                          ret_logit_fwd[l], ret_logit_bwd[l], ret_gn_g[l], ret_gn_b[l],
                          w_br_a[l], w_br_b[l], w_br_c[l], w_o[l])
        x = layer_norm(ALPHA * x + mix, ln2_g[l], ln2_b[l])
        x = layer_norm(ALPHA * x + 0.5 * swiglu(x, ffn2_w_gate[l], ffn2_w_up[l], ffn2_w_down[l]),
                       ln3_g[l], ln3_b[l])
    return x


def setup_inputs(seed: int = 0) -> dict:
    key = jax.random.key(seed)
    keys = list(jax.random.split(key, 40))

    def nrm(shape, scale):
        return jax.random.normal(keys.pop(), shape, jnp.float32) * scale

    def gain(shape):
        return 1.0 + nrm(shape, 0.02)

    ret_base = jnp.asarray(np.log(2.0 ** (5 + np.arange(H_B)) - 1.0), jnp.float32)[None, :]
    return {
        "x_prompt": nrm((BATCH, SEQ, D_MODEL), 1.0),
        "x_sample": nrm((DEC_BATCH, DEC_SEQ, D_MODEL), 1.0),
        "ffn1_w_gate": nrm((DEPTH, D_MODEL, D_FF), D_MODEL ** -0.5),
        "ffn1_w_up": nrm((DEPTH, D_MODEL, D_FF), D_MODEL ** -0.5),
        "ffn1_w_down": nrm((DEPTH, D_FF, D_MODEL), BETA * D_FF ** -0.5),
        "ln1_g": gain((DEPTH, D_MODEL)),
        "ln1_b": nrm((DEPTH, D_MODEL), 0.02),
        "w_in": nrm((DEPTH, D_MODEL, D_IN), D_MODEL ** -0.5),
        "b_in": nrm((DEPTH, D_IN), 0.02),
        "sgu_ln_g": gain((DEPTH, D_A)),
        "sgu_ln_b": nrm((DEPTH, D_A), 0.02),
        "sgu_w": nrm((DEPTH, G_A, CHUNK, CHUNK), CHUNK ** -0.5),
        "sgu_b": gain((DEPTH, G_A, CHUNK)),
        "ret_logit_fwd": ret_base + nrm((DEPTH, H_B), 0.1),
        "ret_logit_bwd": ret_base + nrm((DEPTH, H_B), 0.1),
        "ret_gn_g": gain((DEPTH, D_B)),
        "ret_gn_b": nrm((DEPTH, D_B), 0.02),
        "w_br_a": nrm((DEPTH, D_A, D_MODEL), D_A ** -0.5),
        "w_br_b": nrm((DEPTH, D_B, D_MODEL), D_B ** -0.5),
        "w_br_c": nrm((DEPTH, D_C, D_MODEL), D_C ** -0.5),
        "w_o": nrm((DEPTH, D_MODEL, D_MODEL), BETA * D_MODEL ** -0.5),
        "ln2_g": gain((DEPTH, D_MODEL)),
        "ln2_b": nrm((DEPTH, D_MODEL), 0.02),
        "ffn2_w_gate": nrm((DEPTH, D_MODEL, D_FF), D_MODEL ** -0.5),
        "ffn2_w_up": nrm((DEPTH, D_MODEL, D_FF), D_MODEL ** -0.5),
        "ffn2_w_down": nrm((DEPTH, D_FF, D_MODEL), BETA * D_FF ** -0.5),
        "ln3_g": gain((DEPTH, D_MODEL)),
        "ln3_b": nrm((DEPTH, D_MODEL), 0.02),
    }


def reference(x_prompt, x_sample, ffn1_w_gate, ffn1_w_up, ffn1_w_down, ln1_g, ln1_b, w_in, b_in,
              sgu_ln_g, sgu_ln_b, sgu_w, sgu_b, ret_logit_fwd, ret_logit_bwd, ret_gn_g, ret_gn_b,
              w_br_a, w_br_b, w_br_c, w_o, ln2_g, ln2_b, ffn2_w_gate, ffn2_w_up, ffn2_w_down,
              ln3_g, ln3_b):
    params = (ffn1_w_gate, ffn1_w_up, ffn1_w_down, ln1_g, ln1_b, w_in, b_in, sgu_ln_g, sgu_ln_b,
              sgu_w, sgu_b, ret_logit_fwd, ret_logit_bwd, ret_gn_g, ret_gn_b, w_br_a, w_br_b,
              w_br_c, w_o, ln2_g, ln2_b, ffn2_w_gate, ffn2_w_up, ffn2_w_down, ln3_g, ln3_b)
    y_prompt = trunk(x_prompt, params)
    y_sample = trunk(x_sample, params)
    return (y_prompt, y_sample)
```

```cpp
#include <hip/hip_runtime.h>
namespace pg8 {
#define PG8_LAS __attribute__((address_space(3)))
typedef unsigned short bf16_t;
typedef short bf16x8 __attribute__((ext_vector_type(8)));
typedef float f32x4 __attribute__((ext_vector_type(4)));
typedef unsigned u32x4 __attribute__((ext_vector_type(4)));
constexpr int BM = 256, BK = 64, HALF = 128, HTB = HALF * BK * 2  , STAGE_BYTES = 8 * HTB, NXCD = 8, WGM = 8;

__host__ __device__ __forceinline__ int lds_byte(int r, int c) { const int st = (r >> 4) * 2 + (c >> 5), rr = r & 15, cc = c & 31, ob = rr * 64 + cc * 2; return st * 1024 + (ob ^ (((ob >> 9) & 1) << 5)); }
__host__ __device__ __forceinline__ void stage_rc(int b, int& R, int& C) { const int st = b / 1024, sb = b % 1024, swz = sb ^ (((sb >> 9) & 1) << 5); R = (st >> 1) * 16 + swz / 64; C = (st & 1) * 32 + (swz % 64) / 2; }
__host__ __device__ __forceinline__ int perm32(int rho) { const int n = rho >> 4, i = rho & 15; return 8 * (i >> 2) + 4 * n + (i & 3); }

struct Unit { int pm, pn; };
struct Gemm { const bf16_t* A; const bf16_t* Bt; int M, N, K; };

struct StaticOrder {
    int nM, nN, nwg, G, c;
    __host__ __device__ void init(int M, int N, int G_, int c_) { nM = M / BM; nN = N / BM; nwg = nM * nN; G = G_; c = c_; }
    __host__ __device__ bool next(int i, Unit& u) const {
        const long L = (long)i * G + c; if (L >= nwg) return false;
        int wgid = (int)L; { const int q = nwg / NXCD, r = nwg % NXCD, xcd = wgid % NXCD, off = wgid / NXCD; wgid = (xcd < r ? xcd * (q + 1) : r * (q + 1) + (xcd - r) * q) + off; }
        const int nig = WGM * nN, gid = wgid / nig, fm = gid * WGM, gsz = (nM - fm) < WGM ? (nM - fm) : WGM;
        u.pm = fm + ((wgid % nig) % gsz); u.pn = (wgid % nig) / gsz; return true;
    }
    __device__ __forceinline__ void a_ready(const Unit&) const {}
    __device__ __forceinline__ void done(const Unit&) const {}
};
struct CountedOrder : StaticOrder {
    const unsigned* ready; unsigned need; unsigned* tmo;
    __device__ __forceinline__ void a_ready(const Unit& u) const {
        if (threadIdx.x < 64) {
            const unsigned long long t0 = __builtin_amdgcn_s_memrealtime(); unsigned polls = 0;
            while ((unsigned)__builtin_amdgcn_readfirstlane(__hip_atomic_load(ready + 64 * u.pm, __ATOMIC_RELAXED, __HIP_MEMORY_SCOPE_AGENT)) < need) {
                if ((++polls & 255u) == 0u && __builtin_amdgcn_readfirstlane(__hip_atomic_load(tmo, __ATOMIC_RELAXED, __HIP_MEMORY_SCOPE_AGENT)) != 0u) break;
                if (__builtin_amdgcn_s_memrealtime() - t0 > 2000000ull) {
                    if (threadIdx.x == 0) { unsigned expect = 0u; __hip_atomic_compare_exchange_strong(tmo + 1, &expect, 0x600u | (unsigned)(u.pm & 0xff), __ATOMIC_RELAXED, __ATOMIC_RELAXED, __HIP_MEMORY_SCOPE_AGENT); __hip_atomic_store(tmo, 1u, __ATOMIC_RELAXED, __HIP_MEMORY_SCOPE_AGENT); }
                    break; }
                __builtin_amdgcn_s_sleep(2); }
            __builtin_amdgcn_fence(__ATOMIC_ACQUIRE, "agent");
            asm volatile("s_waitcnt vmcnt(0)" ::: "memory");
        }
#if !defined(BROKEN_HOOK_NO_BARRIER)
        asm volatile("" ::: "memory"); __builtin_amdgcn_s_barrier(); asm volatile("" ::: "memory");
#endif
    }
};

__device__ __forceinline__ unsigned cvt_pk_bf16(float lo, float hi) { unsigned r; asm volatile("v_cvt_pk_bf16_f32 %0, %1, %2" : "=v"(r) : "v"(lo), "v"(hi)); return r; }
typedef float f32x2 __attribute__((ext_vector_type(2)));
__device__ __forceinline__ f32x2 gelu_pk(f32x2 v) {
    const f32x2 av = __builtin_elementwise_abs(v), d = av * 0.2316418882f + 1.0f;
    f32x2 t; t.x = __builtin_amdgcn_rcpf(d.x); t.y = __builtin_amdgcn_rcpf(d.y);
    f32x2 q = t * 0.5307027145f + (-0.7265760135f); q = q * t + 0.7107068705f; q = q * t + (-0.142248368f); q = q * t + 0.127414796f; q = q * t;
    const f32x2 s = (v * v) * (-0.72134752044f);
    f32x2 e; e.x = __builtin_amdgcn_exp2f(s.x); e.y = __builtin_amdgcn_exp2f(s.y);
    const f32x2 m = v * (q * e), r = v - m;
    f32x2 o; o.x = v.x < 0.f ? m.x : r.x; o.y = v.y < 0.f ? m.y : r.y; return o;
}

struct EpiF32 {
    static constexpr bool PERM = false, AFTER_DRAIN = false;
    float* C; int ldc; const float* bias;
    __device__ __forceinline__ void operator()(const f32x4 (&acc)[2][2][4][2], const Unit& u, int wr, int wc, int fr, int fq) const {
        const int row0 = u.pm * BM + wr * 64 + fr, col0 = u.pn * BM + wc * 32 + 4 * fq;
        f32x4 bv[2][2];
#pragma unroll
        for (int bj = 0; bj < 2; ++bj)
#pragma unroll
            for (int n = 0; n < 2; ++n) bv[bj][n] = bias ? *(const f32x4*)(bias + col0 + bj * HALF + n * 16) : (f32x4){0.f, 0.f, 0.f, 0.f};
#pragma unroll
        for (int ai = 0; ai < 2; ++ai)
#pragma unroll
            for (int m = 0; m < 4; ++m) { float* rowp = C + (size_t)(row0 + ai * HALF + m * 16) * ldc + col0;
#pragma unroll
                for (int bj = 0; bj < 2; ++bj)
#pragma unroll
                    for (int n = 0; n < 2; ++n) *(f32x4*)(rowp + bj * HALF + n * 16) = acc[ai][bj][m][n] + bv[bj][n]; }
    }
};
template <int ACT  > struct EpiBf16 {
    static constexpr bool PERM = true, AFTER_DRAIN = false;
    bf16_t* O; int ldc; const float* bias; int split_cols; size_t split_stride;
    __device__ __forceinline__ void operator()(const f32x4 (&acc)[2][2][4][2], const Unit& u, int wr, int wc, int fr, int fq) const {
        const int row0 = u.pm * BM + wr * 64 + fr; int colt = u.pn * BM; bf16_t* base = O;
        if (split_cols) { const int t = colt / split_cols; base += (size_t)t * split_stride; colt -= t * split_cols; }
        const int col0 = colt + wc * 32 + 8 * fq, bcol0 = u.pn * BM + wc * 32 + 8 * fq;
        f32x4 bv[2][2];
#pragma unroll
        for (int bj = 0; bj < 2; ++bj)
#pragma unroll
            for (int n = 0; n < 2; ++n) bv[bj][n] = bias ? *(const f32x4*)(bias + bcol0 + bj * HALF + 4 * n) : (f32x4){0.f, 0.f, 0.f, 0.f};
#pragma unroll
        for (int ai = 0; ai < 2; ++ai)
#pragma unroll
            for (int m = 0; m < 4; ++m) { bf16_t* rowp = base + (size_t)(row0 + ai * HALF + m * 16) * ldc + col0;
#pragma unroll
                for (int bj = 0; bj < 2; ++bj) { f32x4 v0 = acc[ai][bj][m][0] + bv[bj][0], v1 = acc[ai][bj][m][1] + bv[bj][1];
                    if (ACT == 1) { f32x2 a = gelu_pk((f32x2){v0[0], v0[1]}), b = gelu_pk((f32x2){v0[2], v0[3]}), c = gelu_pk((f32x2){v1[0], v1[1]}), d = gelu_pk((f32x2){v1[2], v1[3]});
                        v0 = (f32x4){a.x, a.y, b.x, b.y}; v1 = (f32x4){c.x, c.y, d.x, d.y}; }
                    if (ACT == 2) {
#pragma unroll
                        for (int j = 0; j < 4; ++j) { v0[j] = 0.5f * v0[j] * (1.0f + erff(v0[j] * 0.70710678f)); v1[j] = 0.5f * v1[j] * (1.0f + erff(v1[j] * 0.70710678f)); } }
                    u32x4 w; w.x = cvt_pk_bf16(v0[0], v0[1]); w.y = cvt_pk_bf16(v0[2], v0[3]); w.z = cvt_pk_bf16(v1[0], v1[1]); w.w = cvt_pk_bf16(v1[2], v1[3]);
                    *(u32x4*)(rowp + bj * HALF) = w; } }
    }
};

struct PanelStats {
    unsigned* xbuf;
    unsigned* cnt;
    unsigned* tmo;
    int ntn; float eps;
    unsigned code;
    __device__ __forceinline__ bool run(const f32x4 (&v)[2][2][4][2], const Unit& u, int wr, int wc, int fr, int fq, PG8_LAS unsigned char* lds, int wid, int lane) const {
        typedef float f32x2v __attribute__((ext_vector_type(2)));
        PG8_LAS f32x2v* P = (PG8_LAS f32x2v*)lds;
        PG8_LAS f32x2v* S = (PG8_LAS f32x2v*)(lds + 8192);
        PG8_LAS unsigned* flag = (PG8_LAS unsigned*)(lds + 8192 + 2048);
#pragma unroll
        for (int ai = 0; ai < 2; ++ai)
#pragma unroll
            for (int m = 0; m < 4; ++m) {
                float s = 0.f;
#pragma unroll
                for (int bj = 0; bj < 2; ++bj)
#pragma unroll
                    for (int n = 0; n < 2; ++n) { const f32x4 x = v[ai][bj][m][n]; s += (x[0] + x[1]) + (x[2] + x[3]); }
                s += __shfl_xor(s, 16); s += __shfl_xor(s, 32);
                const float mw = s * (1.0f / 64.0f); float q = 0.f;
#pragma unroll
                for (int bj = 0; bj < 2; ++bj)
#pragma unroll
                    for (int n = 0; n < 2; ++n) { const f32x4 d = v[ai][bj][m][n] - mw; q += (d[0] * d[0] + d[1] * d[1]) + (d[2] * d[2] + d[3] * d[3]); }
                q += __shfl_xor(q, 16); q += __shfl_xor(q, 32);
                if (fq == 0) P[(ai * HALF + wr * 64 + m * 16 + fr) * 4 + wc] = (f32x2v){mw, q};
            }
        asm volatile("s_waitcnt lgkmcnt(0)" ::: "memory"); __builtin_amdgcn_s_barrier(); asm volatile("" ::: "memory");
#if defined(BROKEN_NO_WAIT)
        if (blockIdx.x >= 64) { const long long t0 = clock64(); while (clock64() - t0 < 60000) __builtin_amdgcn_s_sleep(8); }
#endif
        const int row = wid * 32 + (lane & 31);
        if (lane < 32) {
            const f32x2v a = P[row * 4 + 0], b = P[row * 4 + 1], c = P[row * 4 + 2], d = P[row * 4 + 3];
            const float mt = (a.x + b.x + c.x + d.x) * 0.25f;
            const float da = a.x - mt, db = b.x - mt, dc = c.x - mt, dd = d.x - mt;
            const float m2 = (a.y + b.y) + (c.y + d.y) + 64.0f * ((da * da + db * db) + (dc * dc + dd * dd));
            unsigned long long* slot = (unsigned long long*)xbuf + ((size_t)(u.pm * BM + row) * 4 + u.pn);
            __hip_atomic_store(slot, ((unsigned long long)__float_as_uint(m2) << 32) | __float_as_uint(mt), __ATOMIC_RELAXED, __HIP_MEMORY_SCOPE_AGENT);
        }
        asm volatile("s_waitcnt vmcnt(0)" ::: "memory");
        if (lane == 0) __hip_atomic_fetch_add(cnt + 64 * u.pm, 1u, __ATOMIC_RELAXED, __HIP_MEMORY_SCOPE_AGENT);
        if (wid == 0) {
            bool dead = false; const unsigned long long t0 = __builtin_amdgcn_s_memrealtime(); const unsigned want = 8u * (unsigned)ntn;
            for (;;) {
#if defined(BROKEN_NO_WAIT)
                break;
#endif
                if ((unsigned)__builtin_amdgcn_readfirstlane(__hip_atomic_load(cnt + 64 * u.pm, __ATOMIC_RELAXED, __HIP_MEMORY_SCOPE_AGENT)) >= want) break;
                if (__builtin_amdgcn_s_memrealtime() - t0 > 2000000ull) {
                    if (lane == 0) { unsigned expect = 0u; __hip_atomic_compare_exchange_strong(tmo + 1, &expect, code | (unsigned)(u.pm & 0xff), __ATOMIC_RELAXED, __ATOMIC_RELAXED, __HIP_MEMORY_SCOPE_AGENT);
                                     __hip_atomic_store(tmo, 1u, __ATOMIC_RELAXED, __HIP_MEMORY_SCOPE_AGENT); }
                    dead = true; break; }
                __builtin_amdgcn_s_sleep(2);
            }
            __builtin_amdgcn_fence(__ATOMIC_ACQUIRE, "agent");
            if (lane == 0) flag[0] = dead ? 1u : 0u;
        }
        asm volatile("s_waitcnt vmcnt(0) lgkmcnt(0)" ::: "memory"); __builtin_amdgcn_s_barrier(); asm volatile("" ::: "memory");
        const bool bad = flag[0] != 0u;
        if (lane < 32) {
            const unsigned long long* slot = (const unsigned long long*)xbuf + (size_t)(u.pm * BM + row) * 4; float mt[4], m2[4]; float ms = 0.f;
#pragma unroll
            for (int t = 0; t < 4; ++t) { if (t < ntn) { const unsigned long long w = __hip_atomic_load(slot + t, __ATOMIC_RELAXED, __HIP_MEMORY_SCOPE_AGENT); mt[t] = __uint_as_float((unsigned)w); m2[t] = __uint_as_float((unsigned)(w >> 32)); } else { mt[t] = 0.f; m2[t] = 0.f; } ms += mt[t]; }
            const float mean = ms / (float)ntn; float q = 0.f;
#pragma unroll
            for (int t = 0; t < 4; ++t) if (t < ntn) { const float dm = mt[t] - mean; q += m2[t] + 256.0f * dm * dm; }
            S[row] = (f32x2v){mean, 1.0f / sqrtf(q / (256.0f * (float)ntn) + eps)};
        }
        asm volatile("s_waitcnt lgkmcnt(0)" ::: "memory"); __builtin_amdgcn_s_barrier(); asm volatile("" ::: "memory");
        return bad;
    }
};
struct EpiLnRes {
    static constexpr bool PERM = false, AFTER_DRAIN = true;
    const float* base; float* out; int ldc; const float* bias; PanelStats st; unsigned poison;
    __device__ __forceinline__ void refuse(size_t i0, size_t stride, int M, int N) const { const float q = __builtin_nanf(""); for (size_t i = i0; i < (size_t)M * N; i += stride) out[(i / N) * ldc + i % N] = q;
        if (i0 == 0) { unsigned expect = 0u; __hip_atomic_compare_exchange_strong(st.tmo + 1, &expect, 0x7f0u, __ATOMIC_RELAXED, __ATOMIC_RELAXED, __HIP_MEMORY_SCOPE_AGENT); __hip_atomic_store(st.tmo, 1u, __ATOMIC_RELAXED, __HIP_MEMORY_SCOPE_AGENT); } }
    __device__ __forceinline__ void fused(f32x4 (&acc)[2][2][4][2], const Unit& u, int wr, int wc, int fr, int fq, PG8_LAS unsigned char* lds, int wid, int lane) const {
        typedef float f32x2v __attribute__((ext_vector_type(2)));
        const PG8_LAS f32x2v* S = (const PG8_LAS f32x2v*)(lds + 8192);
        const int col0 = u.pn * BM + wc * 32 + 4 * fq;
#pragma unroll
        for (int bj = 0; bj < 2; ++bj)
#pragma unroll
            for (int n = 0; n < 2; ++n) { const f32x4 bv = bias ? *(const f32x4*)(bias + col0 + bj * HALF + n * 16) : (f32x4){0.f, 0.f, 0.f, 0.f};
#pragma unroll
                for (int ai = 0; ai < 2; ++ai)
#pragma unroll
                    for (int m = 0; m < 4; ++m) acc[ai][bj][m][n] += bv; }
        const bool bad = st.run(acc, u, wr, wc, fr, fq, lds, wid, lane) || poison != 0u;
        const float qnan = __builtin_nanf("");
#pragma unroll
        for (int ai = 0; ai < 2; ++ai)
#pragma unroll
            for (int m = 0; m < 4; ++m) { const int r = ai * HALF + wr * 64 + m * 16 + fr; const f32x2v sr = S[r]; const size_t off = (size_t)(u.pm * BM + r) * ldc + col0;
#pragma unroll
                for (int bj = 0; bj < 2; ++bj)
#pragma unroll
                    for (int n = 0; n < 2; ++n) { const f32x4 bs = *(const f32x4*)(base + off + bj * HALF + n * 16); f32x4 o = bs + (acc[ai][bj][m][n] - sr.x) * sr.y;
                        if (bad) o = (f32x4){qnan, qnan, qnan, qnan}; *(f32x4*)(out + off + bj * HALF + n * 16) = o; }
                asm volatile("" ::: "memory"); }
    }
};
struct EpiLnResLn {
    static constexpr bool PERM = false, AFTER_DRAIN = true;
    const float* base; float* out; bf16_t* xn; int ldc; const float* bias; PanelStats st1, st2; unsigned poison;
    __device__ __forceinline__ void refuse(size_t i0, size_t stride, int M, int N) const { const float q = __builtin_nanf(""); for (size_t i = i0; i < (size_t)M * N; i += stride) { const size_t o = (i / N) * ldc + i % N; out[o] = q; xn[o] = (bf16_t)0x7fc0u; }
        if (i0 == 0) { unsigned expect = 0u; __hip_atomic_compare_exchange_strong(st1.tmo + 1, &expect, 0x7f0u, __ATOMIC_RELAXED, __ATOMIC_RELAXED, __HIP_MEMORY_SCOPE_AGENT); __hip_atomic_store(st1.tmo, 1u, __ATOMIC_RELAXED, __HIP_MEMORY_SCOPE_AGENT); } }
    __device__ __forceinline__ void fused(f32x4 (&acc)[2][2][4][2], const Unit& u, int wr, int wc, int fr, int fq, PG8_LAS unsigned char* lds, int wid, int lane) const {
        typedef float f32x2v __attribute__((ext_vector_type(2))); typedef unsigned u32x2v __attribute__((ext_vector_type(2)));
        const PG8_LAS f32x2v* S = (const PG8_LAS f32x2v*)(lds + 8192);
        const int col0 = u.pn * BM + wc * 32 + 4 * fq;
#pragma unroll
        for (int bj = 0; bj < 2; ++bj)
#pragma unroll
            for (int n = 0; n < 2; ++n) { const f32x4 bv = bias ? *(const f32x4*)(bias + col0 + bj * HALF + n * 16) : (f32x4){0.f, 0.f, 0.f, 0.f};
#pragma unroll
                for (int ai = 0; ai < 2; ++ai)
#pragma unroll
                    for (int m = 0; m < 4; ++m) acc[ai][bj][m][n] += bv; }
        bool bad = st1.run(acc, u, wr, wc, fr, fq, lds, wid, lane) || poison != 0u;
        const float qnan = __builtin_nanf("");
#pragma unroll
        for (int ai = 0; ai < 2; ++ai)
#pragma unroll
            for (int m = 0; m < 4; ++m) { const int r = ai * HALF + wr * 64 + m * 16 + fr; const f32x2v sr = S[r]; const size_t off = (size_t)(u.pm * BM + r) * ldc + col0;
#pragma unroll
                for (int bj = 0; bj < 2; ++bj)
#pragma unroll
                    for (int n = 0; n < 2; ++n) { const f32x4 bs = *(const f32x4*)(base + off + bj * HALF + n * 16); acc[ai][bj][m][n] = bs + (acc[ai][bj][m][n] - sr.x) * sr.y; }
                asm volatile("" : "+v"(acc[ai][0][m][0]), "+v"(acc[ai][0][m][1]), "+v"(acc[ai][1][m][0]), "+v"(acc[ai][1][m][1]));
                if (m & 1) asm volatile("" ::: "memory"); }
        const bool bad1 = bad;
        bad = st2.run(acc, u, wr, wc, fr, fq, lds, wid, lane) || bad;
#pragma unroll
        for (int ai = 0; ai < 2; ++ai)
#pragma unroll
            for (int m = 0; m < 4; ++m) { const int r = ai * HALF + wr * 64 + m * 16 + fr; const f32x2v sr = S[r]; const size_t off = (size_t)(u.pm * BM + r) * ldc + col0;
#pragma unroll
                for (int bj = 0; bj < 2; ++bj)
#pragma unroll
                    for (int n = 0; n < 2; ++n) { const f32x4 x1 = acc[ai][bj][m][n]; *(f32x4*)(out + off + bj * HALF + n * 16) = bad1 ? (f32x4){qnan, qnan, qnan, qnan} : x1;
                        const f32x4 o = (x1 - sr.x) * sr.y; u32x2v w; w.x = cvt_pk_bf16(o[0], o[1]); w.y = cvt_pk_bf16(o[2], o[3]);
                        if (bad) { w.x = 0x7fc07fc0u; w.y = 0x7fc07fc0u; } *(u32x2v*)(xn + off + bj * HALF + n * 16) = w; }
                asm volatile("" ::: "memory"); }
    }
};

template <class Epi, class Sched, bool STAMP = false>
__device__ __forceinline__ void gemm_phase(PG8_LAS unsigned char* lds, const Gemm g, const Sched& S, const Epi& E, unsigned long long* stamps) {
    int tid_l = threadIdx.x; asm volatile("" : "+v"(tid_l)); const int tid = tid_l, wid = __builtin_amdgcn_readfirstlane(tid >> 6), lane = tid & 63, wr = wid >> 2, wc = wid & 3, fr = lane & 15, fq = lane >> 4;
    const int K = g.K, nt = K / BK;
    int ts_lo = 0, ts_hi = 0, nts = 0; const unsigned long long rt_entry = STAMP ? (unsigned long long)wall_clock64() : 0ull;
#define PG8_STAMP() do { if (STAMP && wid == 0 && nts < 64) { const unsigned long long _c = (unsigned long long)clock64(); \
        ts_lo = (lane == nts) ? (int)(unsigned)_c : ts_lo; ts_hi = (lane == nts) ? (int)(unsigned)(_c >> 32) : ts_hi; ++nts; } } while (0)
    PG8_STAMP();
    unsigned voffA[2], voffB[2];
#pragma unroll
    for (int i = 0; i < 2; ++i) { int R, C; stage_rc(tid * 16 + i * 8192, R, C); const int Rb = Epi::PERM ? ((R & ~31) + perm32(R & 31)) : R;
        voffA[i] = (unsigned)(R * K + C) * 2u; voffB[i] = (unsigned)(Rb * K + C) * 2u; }
    const size_t kstep = (size_t)(BK * 2);
    const size_t hstep = (size_t)HALF * K * 2;
    const size_t tstep = 2 * hstep;
    const unsigned ldsw = (unsigned)wid * 1024u;
    const int aoff = lds_byte(wr * 64 + fr, fq * 8), boff = lds_byte(wc * 32 + fr, fq * 8);
#define PG8_SA(b, h) (((b) * 2 + (h)) * HTB)
#define PG8_SB(b, h) ((4 + (b) * 2 + (h)) * HTB)
#define PG8_STAGE(bufoff, gbase, voff) do { _Pragma("unroll") for (int _i = 0; _i < 2; ++_i) \
        __builtin_amdgcn_global_load_lds((const unsigned*)((const char*)(gbase) + (voff)[_i]), (PG8_LAS unsigned*)(lds + (bufoff) + ldsw + _i * 8192), 16, 0, 0); } while (0)
#define PG8_LDA(dst, b, h) do { _Pragma("unroll") for (int m = 0; m < 4; ++m) _Pragma("unroll") for (int k = 0; k < 2; ++k) dst[m][k] = *(const PG8_LAS bf16x8*)(lds + PG8_SA(b, h) + aoff + m * 2048 + k * 1024); } while (0)
#define PG8_LDB(dst, b, h) do { _Pragma("unroll") for (int n = 0; n < 2; ++n) _Pragma("unroll") for (int k = 0; k < 2; ++k) dst[n][k] = *(const PG8_LAS bf16x8*)(lds + PG8_SB(b, h) + boff + n * 2048 + k * 1024); } while (0)
#define PG8_MMA(ai, bj, At, Bt) do { __builtin_amdgcn_s_setprio(1); _Pragma("unroll") for (int m = 0; m < 4; ++m) _Pragma("unroll") for (int n = 0; n < 2; ++n) _Pragma("unroll") for (int k = 0; k < 2; ++k) \
        acc[ai][bj][m][n] = __builtin_amdgcn_mfma_f32_16x16x32_bf16(Bt[n][k], At[m][k], acc[ai][bj][m][n], 0, 0, 0); __builtin_amdgcn_s_setprio(0); } while (0)
#define PG8_WAIT_V(n) asm volatile("s_waitcnt vmcnt(" #n ")" ::: "memory")
#define PG8_WAIT_L(n) asm volatile("s_waitcnt lgkmcnt(" #n ")" ::: "memory")
#define PG8_BAR __builtin_amdgcn_s_barrier()
#define PG8_SCHED __builtin_amdgcn_sched_barrier(0)
    Unit cur, nxt; int ui = 0;
    if (!S.next(0, cur)) return;
    f32x4 acc[2][2][4][2];
#pragma unroll
    for (int a = 0; a < 2; ++a)
#pragma unroll
        for (int b = 0; b < 2; ++b)
#pragma unroll
            for (int m = 0; m < 4; ++m)
#pragma unroll
                for (int n = 0; n < 2; ++n) acc[a][b][m][n] = (f32x4){0.f, 0.f, 0.f, 0.f};
    bf16x8 At[4][2], B0[2][2], B1[2][2];
    const char* cA = (const char*)g.A + (size_t)cur.pm * tstep; const char* cB = (const char*)g.Bt + (size_t)cur.pn * tstep;
    S.a_ready(cur);
    PG8_STAGE(PG8_SB(0, 0), cB, voffB); PG8_STAGE(PG8_SA(0, 0), cA, voffA); PG8_STAGE(PG8_SB(0, 1), cB + hstep, voffB); PG8_STAGE(PG8_SA(0, 1), cA + hstep, voffA);
    if (wr == 1) PG8_BAR;
    PG8_WAIT_V(4); PG8_BAR;
    PG8_STAGE(PG8_SB(1, 0), cB + kstep, voffB); PG8_STAGE(PG8_SA(1, 0), cA + kstep, voffA); PG8_STAGE(PG8_SB(1, 1), cB + hstep + kstep, voffB);
    PG8_WAIT_V(6); PG8_BAR;
    PG8_STAMP();
    for (;;) {
        const bool has_next = S.next(ui + 1, nxt);
        const char* nA = has_next ? (const char*)g.A + (size_t)nxt.pm * tstep : cA; const char* nB = has_next ? (const char*)g.Bt + (size_t)nxt.pn * tstep : cB;
        for (int t = 0; t < nt; t += 2) {
            const bool last = (t == nt - 2);
            const char* a1 = cA + (size_t)(t + 1) * kstep;
            const char* a2 = last ? nA : cA + (size_t)(t + 2) * kstep; const char* b2 = last ? nB : cB + (size_t)(t + 2) * kstep;
            const char* a3 = a2 + kstep; const char* b3 = b2 + kstep;
            if (last && has_next) S.a_ready(nxt);
            PG8_LDB(B0, 0, 0); PG8_SCHED; PG8_LDA(At, 0, 0); PG8_STAGE(PG8_SA(1, 1), a1 + hstep, voffA);
            PG8_WAIT_L(8); PG8_BAR; PG8_WAIT_L(0); PG8_MMA(0, 0, At, B0); PG8_BAR; PG8_SCHED;
            PG8_LDB(B1, 0, 1); PG8_STAGE(PG8_SB(0, 0), b2, voffB);
            PG8_BAR; PG8_WAIT_L(0); PG8_MMA(0, 1, At, B1); PG8_BAR;
            PG8_LDA(At, 0, 1); PG8_STAGE(PG8_SA(0, 0), a2, voffA);
            PG8_BAR; PG8_WAIT_L(0); PG8_MMA(1, 0, At, B0); PG8_BAR; PG8_SCHED;
            PG8_STAGE(PG8_SB(0, 1), b2 + hstep, voffB);
            PG8_WAIT_V(6); PG8_BAR; PG8_MMA(1, 1, At, B1); PG8_BAR;
            PG8_LDB(B0, 1, 0); PG8_SCHED; PG8_LDA(At, 1, 0); PG8_STAGE(PG8_SA(0, 1), a2 + hstep, voffA);
            PG8_WAIT_L(8); PG8_BAR; PG8_WAIT_L(0); PG8_MMA(0, 0, At, B0); PG8_BAR; PG8_SCHED;
            PG8_LDB(B1, 1, 1); PG8_STAGE(PG8_SB(1, 0), b3, voffB);
            PG8_BAR; PG8_WAIT_L(0); PG8_MMA(0, 1, At, B1); PG8_BAR;
            PG8_LDA(At, 1, 1); PG8_STAGE(PG8_SA(1, 0), a3, voffA);
            PG8_BAR; PG8_WAIT_L(0); PG8_MMA(1, 0, At, B0); PG8_BAR; PG8_SCHED;
            PG8_STAGE(PG8_SB(1, 1), b3 + hstep, voffB);
            PG8_WAIT_V(6); PG8_BAR; PG8_MMA(1, 1, At, B1); PG8_BAR;
        }
        PG8_STAMP();
        if constexpr (!Epi::AFTER_DRAIN) { E(acc, cur, wr, wc, fr, fq); S.done(cur); }
        PG8_STAMP();
        if (!has_next) break;
#pragma unroll
        for (int a = 0; a < 2; ++a)
#pragma unroll
            for (int b = 0; b < 2; ++b)
#pragma unroll
                for (int m = 0; m < 4; ++m)
#pragma unroll
                    for (int n = 0; n < 2; ++n) acc[a][b][m][n] = (f32x4){0.f, 0.f, 0.f, 0.f};
        cur = nxt; cA = nA; cB = nB; ++ui;
    }
    PG8_WAIT_V(0);
    if (wr == 0) PG8_BAR;
    PG8_BAR;
    if constexpr (Epi::AFTER_DRAIN) { E.fused(acc, cur, wr, wc, fr, fq, lds, wid, lane); S.done(cur); }
    PG8_STAMP();
    if (STAMP && wid == 0) { stamps[lane] = lane < nts ? (((unsigned long long)(unsigned)ts_hi << 32) | (unsigned)ts_lo) : 0ull;
        if (lane == 62) stamps[62] = rt_entry; if (lane == 63) stamps[63] = (unsigned long long)wall_clock64(); }
#undef PG8_STAMP
#undef PG8_SA
#undef PG8_SB
#undef PG8_STAGE
#undef PG8_LDA
#undef PG8_LDB
#undef PG8_MMA
#undef PG8_WAIT_V
#undef PG8_WAIT_L
#undef PG8_BAR
#undef PG8_SCHED
}
}

#include <hip/hip_cooperative_groups.h>
#include <cstdio>
namespace cg = cooperative_groups;
using pg8::bf16x8; using pg8::f32x4; using pg8::u32x4; using pg8::Unit;
typedef unsigned short u16;
typedef unsigned char u8;
typedef unsigned u32x2 __attribute__((ext_vector_type(2)));
#define LAS __attribute__((address_space(3)))

constexpr int S_ROWS = 16384, DM = 1024, DFF = 2816, NWIN = 7168, DIN = 6656;
constexpr float ALPHA_F = 1.4142135623730951f;
constexpr float LN_EPS_F = 1e-5f;
constexpr int PT = 136;
constexpr int TILE_E = 128 * PT;
constexpr int LDS_BYTES = 4 * TILE_E * 2;

constexpr size_t EO_WGU1 = 0, EO_WD1 = 5767168, EO_WGU2 = 8650752, EO_WD2 = 14417920, EO_WIN = 17301504, EO_WBR = 24641536, EO_WO = 26214400, WL_ELEMS = 27262976;
constexpr size_t OFF_W = 0;
constexpr size_t OFF_BIAS = OFF_W + 2 * WL_ELEMS * 2;
constexpr size_t OFF_ROPE = OFF_BIAS + 2 * NWIN * 4;
constexpr size_t OFF_TAB = OFF_ROPE + (size_t)16384 * 64 * 8;
constexpr size_t OFF_XB = OFF_TAB + 81920;
constexpr size_t OFF_GATES = OFF_XB + (size_t)S_ROWS * DM * 2;
constexpr size_t OFF_SEC = OFF_GATES + (size_t)S_ROWS * 3072 * 2;
constexpr size_t SBE = (size_t)S_ROWS * 512;
constexpr size_t WS_NEED = OFF_SEC + 12 * SBE * 2;
enum { SB_U = 0, SB_V = 1, SB_Q = 2, SB_K = 3, SB_VV = 4, SB_G = 5, SB_ZR = 6, SB_ZI = 7, SB_UR = 8, SB_UI = 9, SB_KVF = 10, SB_KVB = 11 };

struct P { const float* in[28]; float* out; u8* ws; };

__device__ __forceinline__ int ltid() { int t = threadIdx.x; asm volatile("" : "+v"(t)); return t; }
__device__ __forceinline__ float bf2f(u16 v) { return __uint_as_float(((unsigned)v) << 16); }
__device__ __forceinline__ unsigned pk2(float lo, float hi) { return pg8::cvt_pk_bf16(lo, hi); }
__device__ __forceinline__ u16 f2bf(float f) { return (u16)(pk2(f, 0.f) & 0xffffu); }
__device__ __forceinline__ void st4bf(u16* p, f32x4 v) { u32x2 w; w.x = pk2(v[0], v[1]); w.y = pk2(v[2], v[3]); *(u32x2*)p = w; }
__device__ __forceinline__ void st4bf_l(LAS u16* p, f32x4 v) { u32x2 w; w.x = pk2(v[0], v[1]); w.y = pk2(v[2], v[3]); *(LAS u32x2*)p = w; }
__device__ __forceinline__ f32x4 ld4bf(const u16* p) { const u32x2 w = *(const u32x2*)p; f32x4 r; r[0] = __uint_as_float(w.x << 16); r[1] = __uint_as_float(w.x & 0xffff0000u); r[2] = __uint_as_float(w.y << 16); r[3] = __uint_as_float(w.y & 0xffff0000u); return r; }
__device__ __forceinline__ float sigmoid_f(float x) { return __builtin_amdgcn_rcpf(1.0f + __expf(-x)); }
__device__ __forceinline__ float gelu_tanh_f(float x) { const float y = 0.7978845608028654f * (x + 0.044715f * x * x * x); return x * sigmoid_f(2.0f * y); }
__device__ __forceinline__ float cos2pi(float frac) { return __builtin_amdgcn_cosf(frac); }
__device__ __forceinline__ float sin2pi(float frac) { return __builtin_amdgcn_sinf(frac); }
__device__ __forceinline__ float log_sigmoid_f(float x) { return -log1pf(expf(-x)); }

struct EpiGateUp {
    static constexpr bool PERM = false, AFTER_DRAIN = false;
    u16* H;
    __device__ __forceinline__ void operator()(const f32x4 (&acc)[2][2][4][2], const Unit& u, int wr, int wc, int fr, int fq) const {
        const int row0 = u.pm * 256 + wr * 64 + fr;
#pragma unroll
        for (int ai = 0; ai < 2; ++ai)
#pragma unroll
            for (int m = 0; m < 4; ++m) { u16* rp = H + (size_t)(row0 + ai * 128 + m * 16) * DFF;
#pragma unroll
                for (int bj = 0; bj < 2; ++bj) { const int j = (u.pn * 8 + bj * 4 + wc) * 16 + 4 * fq; const f32x4 g = acc[ai][bj][m][0], up = acc[ai][bj][m][1]; f32x4 h;
#pragma unroll
                    for (int i = 0; i < 4; ++i) h[i] = g[i] * sigmoid_f(g[i]) * up[i];
                    st4bf(rp + j, h); } }
    }
};
struct EpiResid {
    static constexpr bool PERM = false, AFTER_DRAIN = false;
    const float* xin; float* out; float scale;
    __device__ __forceinline__ void operator()(const f32x4 (&acc)[2][2][4][2], const Unit& u, int wr, int wc, int fr, int fq) const {
        const int row0 = u.pm * 256 + wr * 64 + fr, col0 = u.pn * 256 + wc * 32 + 4 * fq;
#pragma unroll
        for (int ai = 0; ai < 2; ++ai)
#pragma unroll
            for (int m = 0; m < 4; ++m) { const size_t ro = (size_t)(row0 + ai * 128 + m * 16) * DM + col0;
#pragma unroll
                for (int bj = 0; bj < 2; ++bj)
#pragma unroll
                    for (int n = 0; n < 2; ++n) { const size_t o = ro + bj * 128 + n * 16; const f32x4 x = *(const f32x4*)(xin + o); *(f32x4*)(out + o) = x * ALPHA_F + acc[ai][bj][m][n] * scale; } }
    }
};
struct EpiWin {
    static constexpr bool PERM = false, AFTER_DRAIN = false;
    const float* bias; u16* gates; u16* sec; const float* rope; int posmask;
    __device__ __forceinline__ void operator()(const f32x4 (&acc)[2][2][4][2], const Unit& u, int wr, int wc, int fr, int fq) const {
        const int pn = u.pn, row0 = u.pm * 256 + wr * 64 + fr, cs0 = pn * 256 + wc * 32 + 4 * fq;
        f32x4 bv[2][2];
#pragma unroll
        for (int bj = 0; bj < 2; ++bj)
#pragma unroll
            for (int n = 0; n < 2; ++n) bv[bj][n] = *(const f32x4*)(bias + cs0 + bj * 128 + n * 16);
        if (pn < 12) {
#pragma unroll
            for (int ai = 0; ai < 2; ++ai)
#pragma unroll
                for (int m = 0; m < 4; ++m) { u16* rp = gates + (size_t)(row0 + ai * 128 + m * 16) * 3072 + cs0;
#pragma unroll
                    for (int bj = 0; bj < 2; ++bj)
#pragma unroll
                        for (int n = 0; n < 2; ++n) { f32x4 v = acc[ai][bj][m][n] + bv[bj][n];
#pragma unroll
                            for (int i = 0; i < 4; ++i) v[i] = sigmoid_f(v[i]);
                            st4bf(rp + bj * 128 + n * 16, v); } }
        } else if (pn < 16) {
            u16* dst = sec + (size_t)((pn - 12) >> 1) * SBE; const int lc0 = (pn & 1) * 256 + wc * 32 + 4 * fq;
#pragma unroll
            for (int ai = 0; ai < 2; ++ai)
#pragma unroll
                for (int m = 0; m < 4; ++m) { u16* rp = dst + (size_t)(row0 + ai * 128 + m * 16) * 512 + lc0;
#pragma unroll
                    for (int bj = 0; bj < 2; ++bj)
#pragma unroll
                        for (int n = 0; n < 2; ++n) { f32x4 v = acc[ai][bj][m][n] + bv[bj][n];
#pragma unroll
                            for (int i = 0; i < 4; ++i) v[i] = gelu_tanh_f(v[i]);
                            st4bf(rp + bj * 128 + n * 16, v); } }
        } else if (pn < 20) {
            u16* dst = sec + (size_t)(SB_Q + ((pn - 16) >> 1)) * SBE; const float qs = pn < 18 ? 0.08838834764831845f : 1.0f; const int d = 16 * wc + 4 * fq;
#pragma unroll
            for (int ai = 0; ai < 2; ++ai)
#pragma unroll
                for (int m = 0; m < 4; ++m) { const int row = row0 + ai * 128 + m * 16; const float* rp = rope + ((size_t)(row & posmask) * 64 + d) * 2;
                    const f32x4 cs01 = *(const f32x4*)rp, cs23 = *(const f32x4*)(rp + 4);
                    const float c[4] = {cs01[0], cs01[2], cs23[0], cs23[2]}, s[4] = {cs01[1], cs01[3], cs23[1], cs23[3]};
#pragma unroll
                    for (int bj = 0; bj < 2; ++bj) { const f32x4 x1 = acc[ai][bj][m][0] + bv[bj][0], x2 = acc[ai][bj][m][1] + bv[bj][1]; f32x4 o1, o2;
#pragma unroll
                        for (int i = 0; i < 4; ++i) { o1[i] = (x1[i] * c[i] - x2[i] * s[i]) * qs; o2[i] = (x1[i] * s[i] + x2[i] * c[i]) * qs; }
                        u16* op = dst + (size_t)row * 512 + ((pn & 1) * 2 + bj) * 128 + d; st4bf(op, o1); st4bf(op + 64, o2); } }
        } else {
            u16* dst = sec + (size_t)(SB_VV + ((pn - 20) >> 1)) * SBE; const int lc0 = (pn & 1) * 256 + wc * 32 + 4 * fq;
#pragma unroll
            for (int ai = 0; ai < 2; ++ai)
#pragma unroll
                for (int m = 0; m < 4; ++m) { u16* rp = dst + (size_t)(row0 + ai * 128 + m * 16) * 512 + lc0;
#pragma unroll
                    for (int bj = 0; bj < 2; ++bj)
#pragma unroll
                        for (int n = 0; n < 2; ++n) st4bf(rp + bj * 128 + n * 16, acc[ai][bj][m][n] + bv[bj][n]); }
        }
    }
};
template <int PASS> struct EpiMix {
    static constexpr bool PERM = false, AFTER_DRAIN = false;
    const u16* gates; float* m32; u16* m16;
    __device__ __forceinline__ void operator()(const f32x4 (&acc)[2][2][4][2], const Unit& u, int wr, int wc, int fr, int fq) const {
        const int row0 = u.pm * 256 + wr * 64 + fr, col0 = u.pn * 256 + wc * 32 + 4 * fq;
#pragma unroll
        for (int ai = 0; ai < 2; ++ai)
#pragma unroll
            for (int m = 0; m < 4; ++m) { const size_t row = (size_t)(row0 + ai * 128 + m * 16);
#pragma unroll
                for (int bj = 0; bj < 2; ++bj)
#pragma unroll
                    for (int n = 0; n < 2; ++n) { const int col = col0 + bj * 128 + n * 16; const f32x4 g = ld4bf(gates + row * 3072 + PASS * 1024 + col); f32x4 v = g * acc[ai][bj][m][n];
                        float* mp = m32 + row * DM + col;
                        if (PASS == 0) *(f32x4*)mp = v;
                        else if (PASS == 1) *(f32x4*)mp = *(const f32x4*)mp + v;
                        else st4bf(m16 + row * DM + col, *(const f32x4*)mp + v); } }
    }
};

template <class Epi> __device__ __forceinline__ void run_gemm(LAS u8* lds, const u16* A, const u16* Bt, int M, int N, int K, const Epi& E) {
    pg8::Gemm g{A, Bt, M, N, K}; pg8::StaticOrder S; S.init(M, N, (int)gridDim.x, (int)blockIdx.x);
    pg8::gemm_phase<Epi, pg8::StaticOrder, false>(lds, g, S, E, nullptr);
}

template <int MT, int NT, int KS, bool NEGB>
__device__ __forceinline__ void mm_acc(f32x4 (&acc)[MT][NT], const LAS u16* A, int arow, const LAS u16* B, int brow, int fr, int fq) {
#pragma unroll 1
    for (int ks = 0; ks < KS; ++ks) {
        bf16x8 a[MT], b[NT];
#pragma unroll
        for (int m = 0; m < MT; ++m) a[m] = *(const LAS bf16x8*)(A + (arow + 16 * m + fr) * PT + ks * 32 + fq * 8);
#pragma unroll
        for (int n = 0; n < NT; ++n) { b[n] = *(const LAS bf16x8*)(B + (brow + 16 * n + fr) * PT + ks * 32 + fq * 8); if (NEGB) b[n] = b[n] ^ (bf16x8)((short)-32768); }
#pragma unroll
        for (int m = 0; m < MT; ++m)
#pragma unroll
            for (int n = 0; n < NT; ++n) acc[m][n] = __builtin_amdgcn_mfma_f32_16x16x32_bf16(a[m], b[n], acc[m][n], 0, 0, 0);
    }
}
template <int MT, int NT> __device__ __forceinline__ void zero_acc(f32x4 (&acc)[MT][NT]) {
#pragma unroll
    for (int m = 0; m < MT; ++m)
#pragma unroll
        for (int n = 0; n < NT; ++n) acc[m][n] = (f32x4){0.f, 0.f, 0.f, 0.f};
}
__device__ __forceinline__ void stage_N(LAS u16* dst, const u16* src, size_t pitch, int nrows, int lv, int tid) {
    const int total = nrows << lv;
    for (int idx = tid; idx < total; idx += 512) { const int r = idx >> lv, v = idx & ((1 << lv) - 1);
        const u32x4 x = *(const u32x4*)(src + (size_t)r * pitch + v * 8); *(LAS u32x4*)(dst + r * PT + v * 8) = x; }
}
template <class F> __device__ __forceinline__ void stage_T(LAS u16* dst, const u16* src, size_t pitch, int nrows, F f, int tid) {
    const int w = tid >> 6, lane = tid & 63, niter = (nrows >> 6) * 16;
    for (int it = w; it < niter; it += 8) { const int half = it >> 4, v = it & 15, r = half * 64 + lane;
        const u32x4 x = *(const u32x4*)(src + (size_t)r * pitch + v * 8);
#pragma unroll
        for (int e = 0; e < 4; ++e) { const unsigned wd = x[e]; const int c = v * 8 + 2 * e;
            dst[c * PT + r] = f2bf(f(__uint_as_float(wd << 16), r, c)); dst[(c + 1) * PT + r] = f2bf(f(__uint_as_float(wd & 0xffff0000u), r, c + 1)); } }
}

__device__ __forceinline__ void sgu_unit(const P& p, LAS u8* lds, int layer, int cl, int g) {
    const int tid = ltid(), w = tid >> 6, lane = tid & 63, fr = lane & 15, fq = lane >> 4;
    u16* sec = (u16*)(p.ws + OFF_SEC);
    u16* Ub = sec + SB_U * SBE + (size_t)(cl * 128) * 512; const u16* Vb = sec + SB_V * SBE + (size_t)(cl * 128) * 512;
    LAS u16* B0 = (LAS u16*)lds; LAS u16* B1 = B0 + TILE_E; LAS float* st = (LAS float*)(B0 + 2 * TILE_E);
    const float* lng = p.in[9] + layer * 512 + g * 128; const float* lnb = p.in[10] + layer * 512 + g * 128;
    const float* Ws = p.in[11] + ((size_t)layer * 4 + g) * 16384; const float* bs = p.in[12] + (layer * 4 + g) * 128;
    __syncthreads();
    for (int rr = w; rr < 128; rr += 8) {
        const u32x4 x = *(const u32x4*)(Vb + (size_t)rr * 512 + lane * 8); float s = 0.f, q = 0.f;
#pragma unroll
        for (int e = 0; e < 4; ++e) { const float a = __uint_as_float(x[e] << 16), b = __uint_as_float(x[e] & 0xffff0000u); s += a + b; q += a * a + b * b; }
#pragma unroll
        for (int o = 32; o >= 1; o >>= 1) { s += __shfl_xor(s, o); q += __shfl_xor(q, o); }
        if (lane == 0) { const float mean = s * (1.0f / 512.0f), var = q * (1.0f / 512.0f) - mean * mean; st[2 * rr] = mean; st[2 * rr + 1] = rsqrtf(var + LN_EPS_F); }
    }
    for (int idx = tid; idx < 4096; idx += 512) { const int r = idx >> 5, v = idx & 31; const f32x4 x = *(const f32x4*)(Ws + r * 128 + v * 4); st4bf_l(B1 + r * PT + v * 4, x); }
    __syncthreads();
    stage_T(B0, Vb + g * 128, 512, 128, [&](float x, int r, int c) { return (x - st[2 * r]) * st[2 * r + 1] * lng[c] + lnb[c]; }, tid);
    __syncthreads();
    f32x4 acc[2][4]; zero_acc(acc);
    const int c0 = 32 * (w & 3), i0 = 64 * (w >> 2);
    mm_acc<2, 4, 4, false>(acc, B0, c0, B1, i0, fr, fq);
#pragma unroll
    for (int n = 0; n < 4; ++n) { const int i = i0 + 16 * n + fr; const float bb = bs[i];
#pragma unroll
        for (int m = 0; m < 2; ++m) { u16* up = Ub + (size_t)i * 512 + g * 128 + c0 + 16 * m + 4 * fq; const f32x4 uu = ld4bf(up); st4bf(up, uu * (acc[m][n] + bb)); } }
}

__device__ __forceinline__ void kv_unit(const P& p, LAS u8* lds, int layer, int cl, int h) {
    const int tid = ltid(), w = tid >> 6, lane = tid & 63, fr = lane & 15, fq = lane >> 4;
    u16* sec = (u16*)(p.ws + OFF_SEC);
    const u16* K = sec + SB_K * SBE + (size_t)(cl * 128) * 512 + h * 128; const u16* V = sec + SB_VV * SBE + (size_t)(cl * 128) * 512 + h * 128;
    u16* KVF = sec + SB_KVF * SBE + (size_t)(cl * 4 + h) * 16384; u16* KVB = sec + SB_KVB * SBE + (size_t)(cl * 4 + h) * 16384;
    const float lgf = log_sigmoid_f(p.in[13][layer * 4 + h]), lgb = log_sigmoid_f(p.in[14][layer * 4 + h]);
    LAS u16* B0 = (LAS u16*)lds; LAS u16* B1 = B0 + TILE_E; LAS u16* B2 = B0 + 2 * TILE_E;
    __syncthreads();
    stage_T(B0, K, 512, 128, [&](float x, int r, int) { return x * __expf((float)(127 - r) * lgf); }, tid);
    stage_T(B1, K, 512, 128, [&](float x, int r, int) { return x * __expf((float)r * lgb); }, tid);
    stage_T(B2, V, 512, 128, [&](float x, int, int) { return x; }, tid);
    __syncthreads();
    f32x4 aF[2][4], aB[2][4]; zero_acc(aF); zero_acc(aB);
    const int d0 = 32 * (w & 3), e0 = 64 * (w >> 2);
    mm_acc<2, 4, 4, false>(aF, B0, d0, B2, e0, fr, fq);
    mm_acc<2, 4, 4, false>(aB, B1, d0, B2, e0, fr, fq);
#pragma unroll
    for (int n = 0; n < 4; ++n)
#pragma unroll
        for (int m = 0; m < 2; ++m) { const size_t o = (size_t)(e0 + 16 * n + fr) * 128 + d0 + 16 * m + 4 * fq; st4bf(KVF + o, aF[m][n]); st4bf(KVB + o, aB[m][n]); }
}

__device__ __forceinline__ void scan_phase(const P& p, int layer, int nseq, int NC) {
    u16* sec = (u16*)(p.ws + OFF_SEC);
    const int gt = blockIdx.x * 512 + ltid(), total = nseq * 2 * 32768;
    for (int t = gt; t < total; t += gridDim.x * 512) {
        const int pr = t & 32767, dir = (t >> 15) & 1, seq = t >> 16, h = pr >> 13;
        const float lg = log_sigmoid_f(dir ? p.in[14][layer * 4 + h] : p.in[13][layer * 4 + h]); const float dec = __expf(128.0f * lg);
        unsigned* base = (unsigned*)(sec + (dir ? SB_KVB : SB_KVF) * SBE) + (size_t)(seq * NC) * 32768 + pr;
        float s0 = 0.f, s1 = 0.f;
#pragma unroll 4
        for (int k = 0; k < NC; ++k) { const int c = dir ? (NC - 1 - k) : k; unsigned* q = base + (size_t)c * 32768; const unsigned kv = *q;
            *q = pk2(s0, s1); s0 = s0 * dec + __uint_as_float(kv << 16); s1 = s1 * dec + __uint_as_float(kv & 0xffff0000u); }
    }
}

__device__ __forceinline__ void ret_out_unit(const P& p, LAS u8* lds, int layer, int cl, int h) {
    const int tid = ltid(), w = tid >> 6, lane = tid & 63, fr = lane & 15, fq = lane >> 4;
    u16* sec = (u16*)(p.ws + OFF_SEC);
    const size_t rb = (size_t)(cl * 128) * 512 + h * 128;
    u16* Q = sec + SB_Q * SBE + rb; const u16* K = sec + SB_K * SBE + rb; const u16* V = sec + SB_VV * SBE + rb; const u16* G = sec + SB_G * SBE + rb;
    const u16* SF = sec + SB_KVF * SBE + (size_t)(cl * 4 + h) * 16384; const u16* SBk = sec + SB_KVB * SBE + (size_t)(cl * 4 + h) * 16384;
    const float lgf = log_sigmoid_f(p.in[13][layer * 4 + h]), lgb = log_sigmoid_f(p.in[14][layer * 4 + h]);
    LAS u16* B0 = (LAS u16*)lds; LAS u16* B1 = B0 + TILE_E; LAS u16* B2 = B0 + 2 * TILE_E;
    const int i = 16 * w + fr;
    __syncthreads();
    stage_N(B0, Q, 512, 128, 4, tid); stage_N(B1, SF, 128, 128, 4, tid); stage_N(B2, SBk, 128, 128, 4, tid);
    __syncthreads();
    f32x4 aF[8][1], aB[8][1]; zero_acc(aF); zero_acc(aB);
    mm_acc<8, 1, 4, false>(aF, B1, 0, B0, 16 * w, fr, fq);
    mm_acc<8, 1, 4, false>(aB, B2, 0, B0, 16 * w, fr, fq);
    __syncthreads();
    stage_N(B1, K, 512, 128, 4, tid);
    stage_T(B2, V, 512, 128, [&](float x, int, int) { return x; }, tid);
    __syncthreads();
    f32x4 aS[8][1]; zero_acc(aS);
    mm_acc<8, 1, 4, false>(aS, B1, 0, B0, 16 * w, fr, fq);
    __syncthreads();
#pragma unroll
    for (int mm = 0; mm < 8; ++mm) { f32x4 pv;
#pragma unroll
        for (int jj = 0; jj < 4; ++jj) { const int dl = i - (16 * mm + 4 * fq + jj); const float fac = dl >= 0 ? __expf((float)dl * lgf) : __expf((float)(-dl) * lgb); pv[jj] = aS[mm][0][jj] * fac; }
        st4bf_l(B1 + i * PT + 16 * mm + 4 * fq, pv); }
    __syncthreads();
    f32x4 aO[8][1]; zero_acc(aO);
    mm_acc<8, 1, 4, false>(aO, B2, 0, B1, 16 * w, fr, fq);
    const float cf = __expf((float)(i + 1) * lgf), cb = __expf((float)(128 - i) * lgb);
    float s = 0.f;
#pragma unroll
    for (int mm = 0; mm < 8; ++mm) { aO[mm][0] = aO[mm][0] + aF[mm][0] * cf + aB[mm][0] * cb; s += (aO[mm][0][0] + aO[mm][0][1]) + (aO[mm][0][2] + aO[mm][0][3]); }
    s += __shfl_xor(s, 16); s += __shfl_xor(s, 32);
    const float mean = s * (1.0f / 128.0f); float q = 0.f;
#pragma unroll
    for (int mm = 0; mm < 8; ++mm) { const f32x4 dlt = aO[mm][0] - mean; q += (dlt[0] * dlt[0] + dlt[1] * dlt[1]) + (dlt[2] * dlt[2] + dlt[3] * dlt[3]); }
    q += __shfl_xor(q, 16); q += __shfl_xor(q, 32);
    const float rstd = rsqrtf(q * (1.0f / 128.0f) + LN_EPS_F);
    const float* gng = p.in[15] + layer * 512 + h * 128; const float* gnb = p.in[16] + layer * 512 + h * 128;
#pragma unroll
    for (int mm = 0; mm < 8; ++mm) { const int e = 16 * mm + 4 * fq; const f32x4 gg = ld4bf(G + (size_t)i * 512 + e); const f32x4 wg = *(const f32x4*)(gng + e), wb = *(const f32x4*)(gnb + e); f32x4 o;
#pragma unroll
        for (int jj = 0; jj < 4; ++jj) o[jj] = gg[jj] * sigmoid_f(gg[jj]) * ((aO[mm][0][jj] - mean) * rstd * wg[jj] + wb[jj]);
        st4bf(Q + (size_t)i * 512 + e, o); }
}

template <int N, bool STAGE_A>
__device__ __forceinline__ void fft_unit(const P& p, LAS u8* lds, const u16* xr, const u16* xi, size_t kstride, u16* o0, u16* o1, size_t nstride, int l2, int L) {
    const int tid = ltid(), w = tid >> 6, lane = tid & 63, fr = lane & 15, fq = lane >> 4;
    const u16* tabr = (const u16*)(p.ws + OFF_TAB) + (N == 128 ? 0 : 32768); const u16* tabi = tabr + N * N;
    LAS u16* XR = (LAS u16*)lds; LAS u16* XI = XR + TILE_E; LAS u16* FR = XR + 2 * TILE_E; LAS u16* FI = XR + 3 * TILE_E;
    __syncthreads();
    stage_T(XR, xr, kstride, N, [&](float x, int, int) { return x; }, tid);
    stage_T(XI, xi, kstride, N, [&](float x, int, int) { return x; }, tid);
    stage_N(FR, tabr, N, N, N == 128 ? 4 : 3, tid); stage_N(FI, tabi, N, N, N == 128 ? 4 : 3, tid);
    __syncthreads();
    constexpr int NT = N / 32, KS = N / 32;
    const int m0 = 32 * (w & 3), n0 = (N / 2) * (w >> 2);
    f32x4 aR[2][NT]; zero_acc(aR);
    mm_acc<2, NT, KS, false>(aR, XR, m0, FR, n0, fr, fq);
    mm_acc<2, NT, KS, true>(aR, XI, m0, FI, n0, fr, fq);
    if (STAGE_A) {
        f32x4 aI[2][NT]; zero_acc(aI);
        mm_acc<2, NT, KS, false>(aI, XR, m0, FI, n0, fr, fq);
        mm_acc<2, NT, KS, false>(aI, XI, m0, FR, n0, fr, fq);
        const float scale = rsqrtf((float)L);
#pragma unroll
        for (int n = 0; n < NT; ++n) { const int k1 = n0 + 16 * n + fr; const float frac = (float)((l2 * k1) & (L - 1)) / (float)L; const float c = cos2pi(frac) * scale, s = sin2pi(frac) * scale;
#pragma unroll
            for (int m = 0; m < 2; ++m) { const size_t o = (size_t)k1 * nstride + m0 + 16 * m + 4 * fq; const f32x4 r = aR[m][n], im = aI[m][n];
                st4bf(o0 + o, r * c + im * s); st4bf(o1 + o, im * c - r * s); } }
    } else {
#pragma unroll
        for (int n = 0; n < NT; ++n) { const int k2 = n0 + 16 * n + fr;
#pragma unroll
            for (int m = 0; m < 2; ++m) st4bf(o0 + (size_t)k2 * nstride + m0 + 16 * m + 4 * fq, aR[m][n]); }
    }
}

__device__ __forceinline__ void ln_phase(const float* r, float* xo, u16* xb, const float* g, const float* b) {
    const int tid = ltid(), lane = tid & 63, gw = blockIdx.x * 8 + (tid >> 6), nw = gridDim.x * 8;
    for (int row = gw; row < S_ROWS; row += nw) {
        f32x4 v[4]; float s = 0.f;
#pragma unroll
        for (int i = 0; i < 4; ++i) { v[i] = *(const f32x4*)(r + (size_t)row * DM + i * 256 + lane * 4); s += (v[i][0] + v[i][1]) + (v[i][2] + v[i][3]); }
#pragma unroll
        for (int o = 32; o >= 1; o >>= 1) s += __shfl_xor(s, o);
        const float mean = s * (1.0f / 1024.0f); float q = 0.f;
#pragma unroll
        for (int i = 0; i < 4; ++i) { v[i] = v[i] - mean; q += (v[i][0] * v[i][0] + v[i][1] * v[i][1]) + (v[i][2] * v[i][2] + v[i][3] * v[i][3]); }
#pragma unroll
        for (int o = 32; o >= 1; o >>= 1) q += __shfl_xor(q, o);
        const float rstd = rsqrtf(q * (1.0f / 1024.0f) + LN_EPS_F);
#pragma unroll
        for (int i = 0; i < 4; ++i) { const int c = i * 256 + lane * 4; const f32x4 gg = *(const f32x4*)(g + c), bb = *(const f32x4*)(b + c); const f32x4 y = v[i] * rstd * gg + bb;
            *(f32x4*)(xo + (size_t)row * DM + c) = y; st4bf(xb + (size_t)row * DM + c, y); }
    }
}
__device__ __forceinline__ void cvt_phase(const float* x, u16* xb) {
    const size_t n4 = (size_t)S_ROWS * DM / 4;
    for (size_t i = (size_t)blockIdx.x * 512 + ltid(); i < n4; i += (size_t)gridDim.x * 512) st4bf(xb + i * 4, *(const f32x4*)(x + i * 4));
}

template <class CM, class RM> __device__ __forceinline__ void tr_cvt2(u16* dst, int K, int nrows, int ldsrc, CM colptr, RM drow, int gtid, int gth) {
    const int koct = K >> 3; const long total = (long)nrows * koct;
    for (long i = gtid; i < total; i += gth) { const int rho = (int)(i % nrows), ko = (int)(i / nrows);
        const float* s = colptr(rho) + (size_t)ko * 8 * ldsrc;
        const float v0 = s[0], v1 = s[(size_t)ldsrc], v2 = s[(size_t)2 * ldsrc], v3 = s[(size_t)3 * ldsrc], v4 = s[(size_t)4 * ldsrc], v5 = s[(size_t)5 * ldsrc], v6 = s[(size_t)6 * ldsrc], v7 = s[(size_t)7 * ldsrc];
        u32x4 wv; wv[0] = pk2(v0, v1); wv[1] = pk2(v2, v3); wv[2] = pk2(v4, v5); wv[3] = pk2(v6, v7);
        *(u32x4*)(dst + (size_t)drow(rho) * K + ko * 8) = wv; }
}
template <class CM> __device__ __forceinline__ void tr_cvt(u16* dst, int K, int nrows, int ldsrc, CM colptr, int gtid, int gth) { tr_cvt2(dst, K, nrows, ldsrc, colptr, [](int rho) { return rho; }, gtid, gth); }
__device__ __forceinline__ int win_col(int rho) { int col = rho; if (rho >= 4096 && rho < 5120) { const int o = rho & 127; col = (rho - o) + 16 * (o >> 5) + (o & 15) + 64 * ((o >> 4) & 1); } return col; }
__device__ __forceinline__ void prep_phase(const P& p) {
    const int gtid = blockIdx.x * 512 + ltid(), gth = gridDim.x * 512;
#pragma unroll 1
    for (int l = 0; l < 2; ++l) {
        u16* W = (u16*)(p.ws + OFF_W) + (size_t)l * WL_ELEMS;
#pragma unroll 1
        for (int f = 0; f < 2; ++f) {
            const float* wg = p.in[f ? 23 : 2] + (size_t)l * DM * DFF; const float* wu = p.in[f ? 24 : 3] + (size_t)l * DM * DFF; const float* wd = p.in[f ? 25 : 4] + (size_t)l * DFF * DM;
            tr_cvt2(W + (f ? EO_WGU2 : EO_WGU1), DM, DFF, DFF, [=](int j) { return wg + j; }, [](int j) { return (j >> 4) * 32 + (j & 15); }, gtid, gth);
            tr_cvt2(W + (f ? EO_WGU2 : EO_WGU1), DM, DFF, DFF, [=](int j) { return wu + j; }, [](int j) { return (j >> 4) * 32 + 16 + (j & 15); }, gtid, gth);
            tr_cvt(W + (f ? EO_WD2 : EO_WD1), DFF, DM, DM, [=](int rho) { return wd + rho; }, gtid, gth);
        }
        const float* win = p.in[7] + (size_t)l * DM * DIN; const float* bin = p.in[8] + (size_t)l * DIN;
        tr_cvt(W + EO_WIN, DM, 6144, DIN, [=](int rho) { return win + win_col(rho); }, gtid, gth);
#pragma unroll 1
        for (int b = 0; b < 3; ++b) { const float* wb = p.in[17 + b] + (size_t)l * 512 * DM; tr_cvt(W + EO_WBR + (size_t)b * 524288, 512, DM, DM, [=](int rho) { return wb + rho; }, gtid, gth); }
        { const float* wo = p.in[20] + (size_t)l * DM * DM; tr_cvt(W + EO_WO, DM, DM, DM, [=](int rho) { return wo + rho; }, gtid, gth); }
        for (int i = gtid; i < 1024 * 128; i += gth) { const int np = i & 1023, ko = i >> 10, comp = np >> 9, g = (np >> 7) & 3, kc = np & 127;
            float a[8] = {0.f, 0.f, 0.f, 0.f, 0.f, 0.f, 0.f, 0.f}; const float* s = win + (size_t)(ko * 8) * DIN + 6144 + g * 128;
            for (int c = 0; c < 128; ++c) { const float fr_ = (float)((c * kc) & 127) * (1.0f / 128.0f); const float t = (comp ? -sin2pi(fr_) : cos2pi(fr_)) * 0.08838834764831845f;
#pragma unroll
                for (int e = 0; e < 8; ++e) a[e] += s[(size_t)e * DIN + c] * t; }
            u32x4 wv; wv[0] = pk2(a[0], a[1]); wv[1] = pk2(a[2], a[3]); wv[2] = pk2(a[4], a[5]); wv[3] = pk2(a[6], a[7]);
            *(u32x4*)(W + EO_WIN + (size_t)(6144 + np) * DM + ko * 8) = wv; }
        float* bias = (float*)(p.ws + OFF_BIAS) + l * NWIN;
        for (int i = gtid; i < NWIN; i += gth) {
            if (i < 6144) bias[i] = bin[win_col(i)];
            else { const int np = i - 6144, comp = np >> 9, g = (np >> 7) & 3, kc = np & 127; float a = 0.f;
                for (int c = 0; c < 128; ++c) { const float fr_ = (float)((c * kc) & 127) * (1.0f / 128.0f); a += bin[6144 + g * 128 + c] * (comp ? -sin2pi(fr_) : cos2pi(fr_)) * 0.08838834764831845f; }
                bias[i] = a; } }
    }
    float* rope = (float*)(p.ws + OFF_ROPE);
    for (int i = gtid; i < 16384 * 64; i += gth) { const int pos = i >> 6, d = i & 63; const float inv = powf(10000.0f, -(float)d * (1.0f / 64.0f)); const float ang = (float)pos * inv;
        const double t = (double)ang * 0.15915494309189535; const float fr_ = (float)(t - floor(t)); rope[2 * i] = cos2pi(fr_); rope[2 * i + 1] = sin2pi(fr_); }
    u16* tab = (u16*)(p.ws + OFF_TAB);
    for (int i = gtid; i < 16384; i += gth) { const int k = i >> 7, l = i & 127; const float fr_ = (float)((k * l) & 127) * (1.0f / 128.0f); tab[i] = f2bf(cos2pi(fr_)); tab[16384 + i] = f2bf(-sin2pi(fr_)); }
    for (int i = gtid; i < 4096; i += gth) { const int k = i >> 6, l = i & 63; const float fr_ = (float)((k * l) & 63) * (1.0f / 64.0f); tab[32768 + i] = f2bf(cos2pi(fr_)); tab[32768 + 4096 + i] = f2bf(-sin2pi(fr_)); }
}

__global__ void __launch_bounds__(512, 2) mega_fwd(P p) {
    extern __shared__ __attribute__((aligned(16))) unsigned char shm[];
    LAS u8* lds = (LAS u8*)shm;
    cg::grid_group grid = cg::this_grid();
    const int G = (int)gridDim.x, bid = (int)blockIdx.x;
    u16* Xb = (u16*)(p.ws + OFF_XB); u16* gates = (u16*)(p.ws + OFF_GATES); u16* Hb = gates; u16* sec = (u16*)(p.ws + OFF_SEC);
    float* m32 = (float*)(sec + SB_UR * SBE); u16* m16 = sec + SB_K * SBE;

    prep_phase(p);
    grid.sync();
#pragma unroll 1
    for (int slab = 0; slab < 4; ++slab) {
        const float* xin0 = (slab < 2 ? p.in[0] : p.in[1]) + (size_t)(slab & 1) * S_ROWS * DM;
        float* xo = p.out + (size_t)slab * S_ROWS * DM;
        const int L = slab < 2 ? 16384 : 8192, nseq = slab < 2 ? 1 : 2, NC = L / 128;
        cvt_phase(xin0, Xb);
        grid.sync();
#pragma unroll 1
        for (int layer = 0; layer < 2; ++layer) {
            const u16* W = (const u16*)(p.ws + OFF_W) + (size_t)layer * WL_ELEMS;
#pragma unroll 1
            for (int ff = 0; ff < 2; ++ff) {
                const float* xres = (layer == 0 && ff == 0) ? xin0 : xo;
                { EpiGateUp E{Hb}; run_gemm(lds, Xb, W + (ff ? EO_WGU2 : EO_WGU1), S_ROWS, 2 * DFF, DM, E); }
                grid.sync();
                { EpiResid E{xres, xo, 0.5f}; run_gemm(lds, Hb, W + (ff ? EO_WD2 : EO_WD1), S_ROWS, DM, DFF, E); }
                grid.sync();
                ln_phase(xo, xo, Xb, p.in[ff ? 26 : 5] + layer * DM, p.in[ff ? 27 : 6] + layer * DM);
                grid.sync();
                if (ff == 0) {
                    { EpiWin E{(const float*)(p.ws + OFF_BIAS) + layer * NWIN, gates, sec, (const float*)(p.ws + OFF_ROPE), L - 1}; run_gemm(lds, Xb, W + EO_WIN, S_ROWS, NWIN, DM, E); }
                    grid.sync();
                    {
                        const int nfa = nseq * 512, total = 1024 + nfa;
                        for (int u = bid; u < total; u += G) {
                            if (u < 512) sgu_unit(p, lds, layer, u >> 2, u & 3);
                            else if (u < 1024) kv_unit(p, lds, layer, (u - 512) >> 2, u & 3);
                            else { const int v = u - 1024, cb = v & 3, l2 = (v >> 2) & 127, seq = v >> 9; const size_t ro = ((size_t)seq * L + l2) * 512 + cb * 128;
                                if (L == 16384) fft_unit<128, true>(p, lds, sec + SB_ZR * SBE + ro, sec + SB_ZI * SBE + ro, (size_t)128 * 512, sec + SB_UR * SBE + ro, sec + SB_UI * SBE + ro, (size_t)128 * 512, l2, L);
                                else fft_unit<64, true>(p, lds, sec + SB_ZR * SBE + ro, sec + SB_ZI * SBE + ro, (size_t)128 * 512, sec + SB_UR * SBE + ro, sec + SB_UI * SBE + ro, (size_t)128 * 512, l2, L); }
                        }
                    }
                    grid.sync();
                    scan_phase(p, layer, nseq, NC);
                    grid.sync();
                    {
                        for (int u = bid; u < 1024; u += G) {
                            if (u < 512) ret_out_unit(p, lds, layer, u >> 2, u & 3);
                            else { const int v = u - 512, cb = v & 3, kk = v >> 2; const int seq = (L == 16384) ? 0 : (kk >> 6), k1 = (L == 16384) ? kk : (kk & 63);
                                const size_t ri = ((size_t)seq * L + (size_t)k1 * 128) * 512 + cb * 128, rout = ((size_t)seq * L + k1) * 512 + cb * 128;
                                fft_unit<128, false>(p, lds, sec + SB_UR * SBE + ri, sec + SB_UI * SBE + ri, (size_t)512, sec + SB_ZR * SBE + rout, nullptr, (size_t)NC * 512, 0, L); }
                        }
                    }
                    grid.sync();
                    { EpiMix<0> E{gates, m32, m16}; run_gemm(lds, sec + SB_U * SBE, W + EO_WBR, S_ROWS, DM, 512, E); }
                    { EpiMix<1> E{gates, m32, m16}; run_gemm(lds, sec + SB_Q * SBE, W + EO_WBR + 524288, S_ROWS, DM, 512, E); }
                    { EpiMix<2> E{gates, m32, m16}; run_gemm(lds, sec + SB_ZR * SBE, W + EO_WBR + 2 * 524288, S_ROWS, DM, 512, E); }
                    grid.sync();
                    { EpiResid E{xo, xo, 1.0f}; run_gemm(lds, m16, W + EO_WO, S_ROWS, DM, DM, E); }
                    grid.sync();
                    ln_phase(xo, xo, Xb, p.in[21] + layer * DM, p.in[22] + layer * DM);
                    grid.sync();
                }
            }
        }
    }
}

extern "C" void kernel_launch(void* const* d_in, const int* in_sizes, int n_in, void* d_out, int out_size, void* d_ws, size_t ws_size, hipStream_t stream) {
    static int grid = 0;
    if (grid == 0) {
        if (n_in != 28 || ws_size < WS_NEED) { fprintf(stderr, "kernel_launch: unexpected n_in %d or workspace %zu < %zu\n", n_in, ws_size, (size_t)WS_NEED); grid = -1; return; }
        int dev = 0, cus = 0, per_cu = 0;
        (void)hipGetDevice(&dev); (void)hipDeviceGetAttribute(&cus, hipDeviceAttributeMultiprocessorCount, dev);
        if (hipFuncSetAttribute((const void*)mega_fwd, hipFuncAttributeMaxDynamicSharedMemorySize, LDS_BYTES) != hipSuccess) { fprintf(stderr, "kernel_launch: hipFuncSetAttribute failed\n"); grid = -1; return; }
        if (hipOccupancyMaxActiveBlocksPerMultiprocessor(&per_cu, (const void*)mega_fwd, 512, LDS_BYTES) != hipSuccess || per_cu < 1) { fprintf(stderr, "kernel_launch: occupancy query failed (%d)\n", per_cu); (void)hipGetLastError(); per_cu = 1; }
        grid = cus * per_cu;
    }
    if (grid < 0) return;
    P p{};
    for (int i = 0; i < 28; ++i) p.in[i] = (const float*)d_in[i];
    p.out = (float*)d_out; p.ws = (u8*)d_ws;
    void* args[] = {&p};
    hipError_t e = hipLaunchCooperativeKernel((const void*)mega_fwd, dim3(grid), dim3(512), args, LDS_BYTES, stream);
    if (e != hipSuccess) fprintf(stderr, "cooperative launch failed: %s (grid %d)\n", hipGetErrorString(e), grid);
}
```

```cpp
#include <hip/hip_runtime.h>
namespace pg8 {
#define PG8_LAS __attribute__((address_space(3)))
typedef unsigned short bf16_t;
typedef short bf16x8 __attribute__((ext_vector_type(8)));
typedef float f32x4 __attribute__((ext_vector_type(4)));
typedef unsigned u32x4 __attribute__((ext_vector_type(4)));
constexpr int BM = 256, BK = 64, HALF = 128, HTB = HALF * BK * 2  , STAGE_BYTES = 8 * HTB, NXCD = 8, WGM = 8;

__host__ __device__ __forceinline__ int lds_byte(int r, int c) { const int st = (r >> 4) * 2 + (c >> 5), rr = r & 15, cc = c & 31, ob = rr * 64 + cc * 2; return st * 1024 + (ob ^ (((ob >> 9) & 1) << 5)); }
__host__ __device__ __forceinline__ void stage_rc(int b, int& R, int& C) { const int st = b / 1024, sb = b % 1024, swz = sb ^ (((sb >> 9) & 1) << 5); R = (st >> 1) * 16 + swz / 64; C = (st & 1) * 32 + (swz % 64) / 2; }
__host__ __device__ __forceinline__ int perm32(int rho) { const int n = rho >> 4, i = rho & 15; return 8 * (i >> 2) + 4 * n + (i & 3); }

struct Unit { int pm, pn; };
struct Gemm { const bf16_t* A; const bf16_t* Bt; int M, N, K; };

struct StaticOrder {
    int nM, nN, nwg, G, c;
    __host__ __device__ void init(int M, int N, int G_, int c_) { nM = M / BM; nN = N / BM; nwg = nM * nN; G = G_; c = c_; }
    __host__ __device__ bool next(int i, Unit& u) const {
        const long L = (long)i * G + c; if (L >= nwg) return false;
        int wgid = (int)L; { const int q = nwg / NXCD, r = nwg % NXCD, xcd = wgid % NXCD, off = wgid / NXCD; wgid = (xcd < r ? xcd * (q + 1) : r * (q + 1) + (xcd - r) * q) + off; }
        const int nig = WGM * nN, gid = wgid / nig, fm = gid * WGM, gsz = (nM - fm) < WGM ? (nM - fm) : WGM;
        u.pm = fm + ((wgid % nig) % gsz); u.pn = (wgid % nig) / gsz; return true;
    }
    __device__ __forceinline__ void a_ready(const Unit&) const {}
    __device__ __forceinline__ void done(const Unit&) const {}
};
struct CountedOrder : StaticOrder {
    const unsigned* ready; unsigned need; unsigned* tmo;
    __device__ __forceinline__ void a_ready(const Unit& u) const {
        if (threadIdx.x < 64) {
            const unsigned long long t0 = __builtin_amdgcn_s_memrealtime(); unsigned polls = 0;
            while ((unsigned)__builtin_amdgcn_readfirstlane(__hip_atomic_load(ready + 64 * u.pm, __ATOMIC_RELAXED, __HIP_MEMORY_SCOPE_AGENT)) < need) {
                if ((++polls & 255u) == 0u && __builtin_amdgcn_readfirstlane(__hip_atomic_load(tmo, __ATOMIC_RELAXED, __HIP_MEMORY_SCOPE_AGENT)) != 0u) break;
                if (__builtin_amdgcn_s_memrealtime() - t0 > 2000000ull) {
                    if (threadIdx.x == 0) { unsigned expect = 0u; __hip_atomic_compare_exchange_strong(tmo + 1, &expect, 0x600u | (unsigned)(u.pm & 0xff), __ATOMIC_RELAXED, __ATOMIC_RELAXED, __HIP_MEMORY_SCOPE_AGENT); __hip_atomic_store(tmo, 1u, __ATOMIC_RELAXED, __HIP_MEMORY_SCOPE_AGENT); }
                    break; }
                __builtin_amdgcn_s_sleep(2); }
            __builtin_amdgcn_fence(__ATOMIC_ACQUIRE, "agent");
            asm volatile("s_waitcnt vmcnt(0)" ::: "memory");
        }
#if !defined(BROKEN_HOOK_NO_BARRIER)
        asm volatile("" ::: "memory"); __builtin_amdgcn_s_barrier(); asm volatile("" ::: "memory");
#endif
    }
};

__device__ __forceinline__ unsigned cvt_pk_bf16(float lo, float hi) { unsigned r; asm volatile("v_cvt_pk_bf16_f32 %0, %1, %2" : "=v"(r) : "v"(lo), "v"(hi)); return r; }
typedef float f32x2 __attribute__((ext_vector_type(2)));
__device__ __forceinline__ f32x2 gelu_pk(f32x2 v) {
    const f32x2 av = __builtin_elementwise_abs(v), d = av * 0.2316418882f + 1.0f;
    f32x2 t; t.x = __builtin_amdgcn_rcpf(d.x); t.y = __builtin_amdgcn_rcpf(d.y);
    f32x2 q = t * 0.5307027145f + (-0.7265760135f); q = q * t + 0.7107068705f; q = q * t + (-0.142248368f); q = q * t + 0.127414796f; q = q * t;
    const f32x2 s = (v * v) * (-0.72134752044f);
    f32x2 e; e.x = __builtin_amdgcn_exp2f(s.x); e.y = __builtin_amdgcn_exp2f(s.y);
    const f32x2 m = v * (q * e), r = v - m;
    f32x2 o; o.x = v.x < 0.f ? m.x : r.x; o.y = v.y < 0.f ? m.y : r.y; return o;
}

struct EpiF32 {
    static constexpr bool PERM = false, AFTER_DRAIN = false;
    float* C; int ldc; const float* bias;
    __device__ __forceinline__ void operator()(const f32x4 (&acc)[2][2][4][2], const Unit& u, int wr, int wc, int fr, int fq) const {
        const int row0 = u.pm * BM + wr * 64 + fr, col0 = u.pn * BM + wc * 32 + 4 * fq;
        f32x4 bv[2][2];
#pragma unroll
        for (int bj = 0; bj < 2; ++bj)
#pragma unroll
            for (int n = 0; n < 2; ++n) bv[bj][n] = bias ? *(const f32x4*)(bias + col0 + bj * HALF + n * 16) : (f32x4){0.f, 0.f, 0.f, 0.f};
#pragma unroll
        for (int ai = 0; ai < 2; ++ai)
#pragma unroll
            for (int m = 0; m < 4; ++m) { float* rowp = C + (size_t)(row0 + ai * HALF + m * 16) * ldc + col0;
#pragma unroll
                for (int bj = 0; bj < 2; ++bj)
#pragma unroll
                    for (int n = 0; n < 2; ++n) *(f32x4*)(rowp + bj * HALF + n * 16) = acc[ai][bj][m][n] + bv[bj][n]; }
    }
};
template <int ACT  > struct EpiBf16 {
    static constexpr bool PERM = true, AFTER_DRAIN = false;
    bf16_t* O; int ldc; const float* bias; int split_cols; size_t split_stride;
    __device__ __forceinline__ void operator()(const f32x4 (&acc)[2][2][4][2], const Unit& u, int wr, int wc, int fr, int fq) const {
        const int row0 = u.pm * BM + wr * 64 + fr; int colt = u.pn * BM; bf16_t* base = O;
        if (split_cols) { const int t = colt / split_cols; base += (size_t)t * split_stride; colt -= t * split_cols; }
        const int col0 = colt + wc * 32 + 8 * fq, bcol0 = u.pn * BM + wc * 32 + 8 * fq;
        f32x4 bv[2][2];
#pragma unroll
        for (int bj = 0; bj < 2; ++bj)
#pragma unroll
            for (int n = 0; n < 2; ++n) bv[bj][n] = bias ? *(const f32x4*)(bias + bcol0 + bj * HALF + 4 * n) : (f32x4){0.f, 0.f, 0.f, 0.f};
#pragma unroll
        for (int ai = 0; ai < 2; ++ai)
#pragma unroll
            for (int m = 0; m < 4; ++m) { bf16_t* rowp = base + (size_t)(row0 + ai * HALF + m * 16) * ldc + col0;
#pragma unroll
                for (int bj = 0; bj < 2; ++bj) { f32x4 v0 = acc[ai][bj][m][0] + bv[bj][0], v1 = acc[ai][bj][m][1] + bv[bj][1];
                    if (ACT == 1) { f32x2 a = gelu_pk((f32x2){v0[0], v0[1]}), b = gelu_pk((f32x2){v0[2], v0[3]}), c = gelu_pk((f32x2){v1[0], v1[1]}), d = gelu_pk((f32x2){v1[2], v1[3]});
                        v0 = (f32x4){a.x, a.y, b.x, b.y}; v1 = (f32x4){c.x, c.y, d.x, d.y}; }
                    if (ACT == 2) {
#pragma unroll
                        for (int j = 0; j < 4; ++j) { v0[j] = 0.5f * v0[j] * (1.0f + erff(v0[j] * 0.70710678f)); v1[j] = 0.5f * v1[j] * (1.0f + erff(v1[j] * 0.70710678f)); } }
                    u32x4 w; w.x = cvt_pk_bf16(v0[0], v0[1]); w.y = cvt_pk_bf16(v0[2], v0[3]); w.z = cvt_pk_bf16(v1[0], v1[1]); w.w = cvt_pk_bf16(v1[2], v1[3]);
                    *(u32x4*)(rowp + bj * HALF) = w; } }
    }
};

struct PanelStats {
    unsigned* xbuf;
    unsigned* cnt;
    unsigned* tmo;
    int ntn; float eps;
    unsigned code;
    __device__ __forceinline__ bool run(const f32x4 (&v)[2][2][4][2], const Unit& u, int wr, int wc, int fr, int fq, PG8_LAS unsigned char* lds, int wid, int lane) const {
        typedef float f32x2v __attribute__((ext_vector_type(2)));
        PG8_LAS f32x2v* P = (PG8_LAS f32x2v*)lds;
        PG8_LAS f32x2v* S = (PG8_LAS f32x2v*)(lds + 8192);
        PG8_LAS unsigned* flag = (PG8_LAS unsigned*)(lds + 8192 + 2048);
#pragma unroll
        for (int ai = 0; ai < 2; ++ai)
#pragma unroll
            for (int m = 0; m < 4; ++m) {
                float s = 0.f;
#pragma unroll
                for (int bj = 0; bj < 2; ++bj)
#pragma unroll
                    for (int n = 0; n < 2; ++n) { const f32x4 x = v[ai][bj][m][n]; s += (x[0] + x[1]) + (x[2] + x[3]); }
                s += __shfl_xor(s, 16); s += __shfl_xor(s, 32);
                const float mw = s * (1.0f / 64.0f); float q = 0.f;
#pragma unroll
                for (int bj = 0; bj < 2; ++bj)
#pragma unroll
                    for (int n = 0; n < 2; ++n) { const f32x4 d = v[ai][bj][m][n] - mw; q += (d[0] * d[0] + d[1] * d[1]) + (d[2] * d[2] + d[3] * d[3]); }
                q += __shfl_xor(q, 16); q += __shfl_xor(q, 32);
                if (fq == 0) P[(ai * HALF + wr * 64 + m * 16 + fr) * 4 + wc] = (f32x2v){mw, q};
            }
        asm volatile("s_waitcnt lgkmcnt(0)" ::: "memory"); __builtin_amdgcn_s_barrier(); asm volatile("" ::: "memory");
#if defined(BROKEN_NO_WAIT)
        if (blockIdx.x >= 64) { const long long t0 = clock64(); while (clock64() - t0 < 60000) __builtin_amdgcn_s_sleep(8); }
#endif
        const int row = wid * 32 + (lane & 31);
        if (lane < 32) {
            const f32x2v a = P[row * 4 + 0], b = P[row * 4 + 1], c = P[row * 4 + 2], d = P[row * 4 + 3];
            const float mt = (a.x + b.x + c.x + d.x) * 0.25f;
            const float da = a.x - mt, db = b.x - mt, dc = c.x - mt, dd = d.x - mt;
            const float m2 = (a.y + b.y) + (c.y + d.y) + 64.0f * ((da * da + db * db) + (dc * dc + dd * dd));
            unsigned long long* slot = (unsigned long long*)xbuf + ((size_t)(u.pm * BM + row) * 4 + u.pn);
            __hip_atomic_store(slot, ((unsigned long long)__float_as_uint(m2) << 32) | __float_as_uint(mt), __ATOMIC_RELAXED, __HIP_MEMORY_SCOPE_AGENT);
        }
        asm volatile("s_waitcnt vmcnt(0)" ::: "memory");
        if (lane == 0) __hip_atomic_fetch_add(cnt + 64 * u.pm, 1u, __ATOMIC_RELAXED, __HIP_MEMORY_SCOPE_AGENT);
        if (wid == 0) {
            bool dead = false; const unsigned long long t0 = __builtin_amdgcn_s_memrealtime(); const unsigned want = 8u * (unsigned)ntn;
            for (;;) {
#if defined(BROKEN_NO_WAIT)
                break;
#endif
                if ((unsigned)__builtin_amdgcn_readfirstlane(__hip_atomic_load(cnt + 64 * u.pm, __ATOMIC_RELAXED, __HIP_MEMORY_SCOPE_AGENT)) >= want) break;
                if (__builtin_amdgcn_s_memrealtime() - t0 > 2000000ull) {
                    if (lane == 0) { unsigned expect = 0u; __hip_atomic_compare_exchange_strong(tmo + 1, &expect, code | (unsigned)(u.pm & 0xff), __ATOMIC_RELAXED, __ATOMIC_RELAXED, __HIP_MEMORY_SCOPE_AGENT);
                                     __hip_atomic_store(tmo, 1u, __ATOMIC_RELAXED, __HIP_MEMORY_SCOPE_AGENT); }
                    dead = true; break; }
                __builtin_amdgcn_s_sleep(2);
            }
            __builtin_amdgcn_fence(__ATOMIC_ACQUIRE, "agent");
            if (lane == 0) flag[0] = dead ? 1u : 0u;
        }
        asm volatile("s_waitcnt vmcnt(0) lgkmcnt(0)" ::: "memory"); __builtin_amdgcn_s_barrier(); asm volatile("" ::: "memory");
        const bool bad = flag[0] != 0u;
        if (lane < 32) {
            const unsigned long long* slot = (const unsigned long long*)xbuf + (size_t)(u.pm * BM + row) * 4; float mt[4], m2[4]; float ms = 0.f;
#pragma unroll
            for (int t = 0; t < 4; ++t) { if (t < ntn) { const unsigned long long w = __hip_atomic_load(slot + t, __ATOMIC_RELAXED, __HIP_MEMORY_SCOPE_AGENT); mt[t] = __uint_as_float((unsigned)w); m2[t] = __uint_as_float((unsigned)(w >> 32)); } else { mt[t] = 0.f; m2[t] = 0.f; } ms += mt[t]; }
            const float mean = ms / (float)ntn; float q = 0.f;
#pragma unroll
            for (int t = 0; t < 4; ++t) if (t < ntn) { const float dm = mt[t] - mean; q += m2[t] + 256.0f * dm * dm; }
            S[row] = (f32x2v){mean, 1.0f / sqrtf(q / (256.0f * (float)ntn) + eps)};
        }
        asm volatile("s_waitcnt lgkmcnt(0)" ::: "memory"); __builtin_amdgcn_s_barrier(); asm volatile("" ::: "memory");
        return bad;
    }
};
struct EpiLnRes {
    static constexpr bool PERM = false, AFTER_DRAIN = true;
    const float* base; float* out; int ldc; const float* bias; PanelStats st; unsigned poison;
    __device__ __forceinline__ void refuse(size_t i0, size_t stride, int M, int N) const { const float q = __builtin_nanf(""); for (size_t i = i0; i < (size_t)M * N; i += stride) out[(i / N) * ldc + i % N] = q;
        if (i0 == 0) { unsigned expect = 0u; __hip_atomic_compare_exchange_strong(st.tmo + 1, &expect, 0x7f0u, __ATOMIC_RELAXED, __ATOMIC_RELAXED, __HIP_MEMORY_SCOPE_AGENT); __hip_atomic_store(st.tmo, 1u, __ATOMIC_RELAXED, __HIP_MEMORY_SCOPE_AGENT); } }
    __device__ __forceinline__ void fused(f32x4 (&acc)[2][2][4][2], const Unit& u, int wr, int wc, int fr, int fq, PG8_LAS unsigned char* lds, int wid, int lane) const {
        typedef float f32x2v __attribute__((ext_vector_type(2)));
        const PG8_LAS f32x2v* S = (const PG8_LAS f32x2v*)(lds + 8192);
        const int col0 = u.pn * BM + wc * 32 + 4 * fq;
#pragma unroll
        for (int bj = 0; bj < 2; ++bj)
#pragma unroll
            for (int n = 0; n < 2; ++n) { const f32x4 bv = bias ? *(const f32x4*)(bias + col0 + bj * HALF + n * 16) : (f32x4){0.f, 0.f, 0.f, 0.f};
#pragma unroll
                for (int ai = 0; ai < 2; ++ai)
#pragma unroll
                    for (int m = 0; m < 4; ++m) acc[ai][bj][m][n] += bv; }
        const bool bad = st.run(acc, u, wr, wc, fr, fq, lds, wid, lane) || poison != 0u;
        const float qnan = __builtin_nanf("");
#pragma unroll
        for (int ai = 0; ai < 2; ++ai)
#pragma unroll
            for (int m = 0; m < 4; ++m) { const int r = ai * HALF + wr * 64 + m * 16 + fr; const f32x2v sr = S[r]; const size_t off = (size_t)(u.pm * BM + r) * ldc + col0;
#pragma unroll
                for (int bj = 0; bj < 2; ++bj)
#pragma unroll
                    for (int n = 0; n < 2; ++n) { const f32x4 bs = *(const f32x4*)(base + off + bj * HALF + n * 16); f32x4 o = bs + (acc[ai][bj][m][n] - sr.x) * sr.y;
                        if (bad) o = (f32x4){qnan, qnan, qnan, qnan}; *(f32x4*)(out + off + bj * HALF + n * 16) = o; }
                asm volatile("" ::: "memory"); }
    }
};
struct EpiLnResLn {
    static constexpr bool PERM = false, AFTER_DRAIN = true;
    const float* base; float* out; bf16_t* xn; int ldc; const float* bias; PanelStats st1, st2; unsigned poison;
    __device__ __forceinline__ void refuse(size_t i0, size_t stride, int M, int N) const { const float q = __builtin_nanf(""); for (size_t i = i0; i < (size_t)M * N; i += stride) { const size_t o = (i / N) * ldc + i % N; out[o] = q; xn[o] = (bf16_t)0x7fc0u; }
        if (i0 == 0) { unsigned expect = 0u; __hip_atomic_compare_exchange_strong(st1.tmo + 1, &expect, 0x7f0u, __ATOMIC_RELAXED, __ATOMIC_RELAXED, __HIP_MEMORY_SCOPE_AGENT); __hip_atomic_store(st1.tmo, 1u, __ATOMIC_RELAXED, __HIP_MEMORY_SCOPE_AGENT); } }
    __device__ __forceinline__ void fused(f32x4 (&acc)[2][2][4][2], const Unit& u, int wr, int wc, int fr, int fq, PG8_LAS unsigned char* lds, int wid, int lane) const {
        typedef float f32x2v __attribute__((ext_vector_type(2))); typedef unsigned u32x2v __attribute__((ext_vector_type(2)));
        const PG8_LAS f32x2v* S = (const PG8_LAS f32x2v*)(lds + 8192);
        const int col0 = u.pn * BM + wc * 32 + 4 * fq;
#pragma unroll
        for (int bj = 0; bj < 2; ++bj)
#pragma unroll
            for (int n = 0; n < 2; ++n) { const f32x4 bv = bias ? *(const f32x4*)(bias + col0 + bj * HALF + n * 16) : (f32x4){0.f, 0.f, 0.f, 0.f};
#pragma unroll
                for (int ai = 0; ai < 2; ++ai)
#pragma unroll
                    for (int m = 0; m < 4; ++m) acc[ai][bj][m][n] += bv; }
        bool bad = st1.run(acc, u, wr, wc, fr, fq, lds, wid, lane) || poison != 0u;
        const float qnan = __builtin_nanf("");
#pragma unroll
        for (int ai = 0; ai < 2; ++ai)
#pragma unroll
            for (int m = 0; m < 4; ++m) { const int r = ai * HALF + wr * 64 + m * 16 + fr; const f32x2v sr = S[r]; const size_t off = (size_t)(u.pm * BM + r) * ldc + col0;
#pragma unroll
                for (int bj = 0; bj < 2; ++bj)
#pragma unroll
                    for (int n = 0; n < 2; ++n) { const f32x4 bs = *(const f32x4*)(base + off + bj * HALF + n * 16); acc[ai][bj][m][n] = bs + (acc[ai][bj][m][n] - sr.x) * sr.y; }
                asm volatile("" : "+v"(acc[ai][0][m][0]), "+v"(acc[ai][0][m][1]), "+v"(acc[ai][1][m][0]), "+v"(acc[ai][1][m][1]));
                if (m & 1) asm volatile("" ::: "memory"); }
        const bool bad1 = bad;
        bad = st2.run(acc, u, wr, wc, fr, fq, lds, wid, lane) || bad;
#pragma unroll
        for (int ai = 0; ai < 2; ++ai)
#pragma unroll
            for (int m = 0; m < 4; ++m) { const int r = ai * HALF + wr * 64 + m * 16 + fr; const f32x2v sr = S[r]; const size_t off = (size_t)(u.pm * BM + r) * ldc + col0;
#pragma unroll
                for (int bj = 0; bj < 2; ++bj)
#pragma unroll
                    for (int n = 0; n < 2; ++n) { const f32x4 x1 = acc[ai][bj][m][n]; *(f32x4*)(out + off + bj * HALF + n * 16) = bad1 ? (f32x4){qnan, qnan, qnan, qnan} : x1;
                        const f32x4 o = (x1 - sr.x) * sr.y; u32x2v w; w.x = cvt_pk_bf16(o[0], o[1]); w.y = cvt_pk_bf16(o[2], o[3]);
                        if (bad) { w.x = 0x7fc07fc0u; w.y = 0x7fc07fc0u; } *(u32x2v*)(xn + off + bj * HALF + n * 16) = w; }
                asm volatile("" ::: "memory"); }
    }
};

template <class Epi, class Sched, bool STAMP = false>
__device__ __forceinline__ void gemm_phase(PG8_LAS unsigned char* lds, const Gemm g, const Sched& S, const Epi& E, unsigned long long* stamps) {
    int tid_l = threadIdx.x; asm volatile("" : "+v"(tid_l)); const int tid = tid_l, wid = __builtin_amdgcn_readfirstlane(tid >> 6), lane = tid & 63, wr = wid >> 2, wc = wid & 3, fr = lane & 15, fq = lane >> 4;
    const int K = g.K, nt = K / BK;
    int ts_lo = 0, ts_hi = 0, nts = 0; const unsigned long long rt_entry = STAMP ? (unsigned long long)wall_clock64() : 0ull;
#define PG8_STAMP() do { if (STAMP && wid == 0 && nts < 64) { const unsigned long long _c = (unsigned long long)clock64(); \
        ts_lo = (lane == nts) ? (int)(unsigned)_c : ts_lo; ts_hi = (lane == nts) ? (int)(unsigned)(_c >> 32) : ts_hi; ++nts; } } while (0)
    PG8_STAMP();
    unsigned voffA[2], voffB[2];
#pragma unroll
    for (int i = 0; i < 2; ++i) { int R, C; stage_rc(tid * 16 + i * 8192, R, C); const int Rb = Epi::PERM ? ((R & ~31) + perm32(R & 31)) : R;
        voffA[i] = (unsigned)(R * K + C) * 2u; voffB[i] = (unsigned)(Rb * K + C) * 2u; }
    const size_t kstep = (size_t)(BK * 2);
    const size_t hstep = (size_t)HALF * K * 2;
    const size_t tstep = 2 * hstep;
    const unsigned ldsw = (unsigned)wid * 1024u;
    const int aoff = lds_byte(wr * 64 + fr, fq * 8), boff = lds_byte(wc * 32 + fr, fq * 8);
#define PG8_SA(b, h) (((b) * 2 + (h)) * HTB)
#define PG8_SB(b, h) ((4 + (b) * 2 + (h)) * HTB)
#define PG8_STAGE(bufoff, gbase, voff) do { _Pragma("unroll") for (int _i = 0; _i < 2; ++_i) \
        __builtin_amdgcn_global_load_lds((const unsigned*)((const char*)(gbase) + (voff)[_i]), (PG8_LAS unsigned*)(lds + (bufoff) + ldsw + _i * 8192), 16, 0, 0); } while (0)
#define PG8_LDA(dst, b, h) do { _Pragma("unroll") for (int m = 0; m < 4; ++m) _Pragma("unroll") for (int k = 0; k < 2; ++k) dst[m][k] = *(const PG8_LAS bf16x8*)(lds + PG8_SA(b, h) + aoff + m * 2048 + k * 1024); } while (0)
#define PG8_LDB(dst, b, h) do { _Pragma("unroll") for (int n = 0; n < 2; ++n) _Pragma("unroll") for (int k = 0; k < 2; ++k) dst[n][k] = *(const PG8_LAS bf16x8*)(lds + PG8_SB(b, h) + boff + n * 2048 + k * 1024); } while (0)
#define PG8_MMA(ai, bj, At, Bt) do { __builtin_amdgcn_s_setprio(1); _Pragma("unroll") for (int m = 0; m < 4; ++m) _Pragma("unroll") for (int n = 0; n < 2; ++n) _Pragma("unroll") for (int k = 0; k < 2; ++k) \
        acc[ai][bj][m][n] = __builtin_amdgcn_mfma_f32_16x16x32_bf16(Bt[n][k], At[m][k], acc[ai][bj][m][n], 0, 0, 0); __builtin_amdgcn_s_setprio(0); } while (0)
#define PG8_WAIT_V(n) asm volatile("s_waitcnt vmcnt(" #n ")" ::: "memory")
#define PG8_WAIT_L(n) asm volatile("s_waitcnt lgkmcnt(" #n ")" ::: "memory")
#define PG8_BAR __builtin_amdgcn_s_barrier()
#define PG8_SCHED __builtin_amdgcn_sched_barrier(0)
    Unit cur, nxt; int ui = 0;
    if (!S.next(0, cur)) return;
    f32x4 acc[2][2][4][2];
#pragma unroll
    for (int a = 0; a < 2; ++a)
#pragma unroll
        for (int b = 0; b < 2; ++b)
#pragma unroll
            for (int m = 0; m < 4; ++m)
#pragma unroll
                for (int n = 0; n < 2; ++n) acc[a][b][m][n] = (f32x4){0.f, 0.f, 0.f, 0.f};
    bf16x8 At[4][2], B0[2][2], B1[2][2];
    const char* cA = (const char*)g.A + (size_t)cur.pm * tstep; const char* cB = (const char*)g.Bt + (size_t)cur.pn * tstep;
    S.a_ready(cur);
    PG8_STAGE(PG8_SB(0, 0), cB, voffB); PG8_STAGE(PG8_SA(0, 0), cA, voffA); PG8_STAGE(PG8_SB(0, 1), cB + hstep, voffB); PG8_STAGE(PG8_SA(0, 1), cA + hstep, voffA);
    if (wr == 1) PG8_BAR;
    PG8_WAIT_V(4); PG8_BAR;
    PG8_STAGE(PG8_SB(1, 0), cB + kstep, voffB); PG8_STAGE(PG8_SA(1, 0), cA + kstep, voffA); PG8_STAGE(PG8_SB(1, 1), cB + hstep + kstep, voffB);
    PG8_WAIT_V(6); PG8_BAR;
    PG8_STAMP();
    for (;;) {
        const bool has_next = S.next(ui + 1, nxt);
        const char* nA = has_next ? (const char*)g.A + (size_t)nxt.pm * tstep : cA; const char* nB = has_next ? (const char*)g.Bt + (size_t)nxt.pn * tstep : cB;
        for (int t = 0; t < nt; t += 2) {
            const bool last = (t == nt - 2);
            const char* a1 = cA + (size_t)(t + 1) * kstep;
            const char* a2 = last ? nA : cA + (size_t)(t + 2) * kstep; const char* b2 = last ? nB : cB + (size_t)(t + 2) * kstep;
            const char* a3 = a2 + kstep; const char* b3 = b2 + kstep;
            if (last && has_next) S.a_ready(nxt);
            PG8_LDB(B0, 0, 0); PG8_SCHED; PG8_LDA(At, 0, 0); PG8_STAGE(PG8_SA(1, 1), a1 + hstep, voffA);
            PG8_WAIT_L(8); PG8_BAR; PG8_WAIT_L(0); PG8_MMA(0, 0, At, B0); PG8_BAR; PG8_SCHED;
            PG8_LDB(B1, 0, 1); PG8_STAGE(PG8_SB(0, 0), b2, voffB);
            PG8_BAR; PG8_WAIT_L(0); PG8_MMA(0, 1, At, B1); PG8_BAR;
            PG8_LDA(At, 0, 1); PG8_STAGE(PG8_SA(0, 0), a2, voffA);
            PG8_BAR; PG8_WAIT_L(0); PG8_MMA(1, 0, At, B0); PG8_BAR; PG8_SCHED;
            PG8_STAGE(PG8_SB(0, 1), b2 + hstep, voffB);
            PG8_WAIT_V(6); PG8_BAR; PG8_MMA(1, 1, At, B1); PG8_BAR;
            PG8_LDB(B0, 1, 0); PG8_SCHED; PG8_LDA(At, 1, 0); PG8_STAGE(PG8_SA(0, 1), a2 + hstep, voffA);
            PG8_WAIT_L(8); PG8_BAR; PG8_WAIT_L(0); PG8_MMA(0, 0, At, B0); PG8_BAR; PG8_SCHED;
            PG8_LDB(B1, 1, 1); PG8_STAGE(PG8_SB(1, 0), b3, voffB);
            PG8_BAR; PG8_WAIT_L(0); PG8_MMA(0, 1, At, B1); PG8_BAR;
            PG8_LDA(At, 1, 1); PG8_STAGE(PG8_SA(1, 0), a3, voffA);
            PG8_BAR; PG8_WAIT_L(0); PG8_MMA(1, 0, At, B0); PG8_BAR; PG8_SCHED;
            PG8_STAGE(PG8_SB(1, 1), b3 + hstep, voffB);
            PG8_WAIT_V(6); PG8_BAR; PG8_MMA(1, 1, At, B1); PG8_BAR;
        }
        PG8_STAMP();
        if constexpr (!Epi::AFTER_DRAIN) { E(acc, cur, wr, wc, fr, fq); S.done(cur); }
        PG8_STAMP();
        if (!has_next) break;
#pragma unroll
        for (int a = 0; a < 2; ++a)
#pragma unroll
            for (int b = 0; b < 2; ++b)
#pragma unroll
                for (int m = 0; m < 4; ++m)
#pragma unroll
                    for (int n = 0; n < 2; ++n) acc[a][b][m][n] = (f32x4){0.f, 0.f, 0.f, 0.f};
        cur = nxt; cA = nA; cB = nB; ++ui;
    }
    PG8_WAIT_V(0);
    if (wr == 0) PG8_BAR;
    PG8_BAR;
    if constexpr (Epi::AFTER_DRAIN) { E.fused(acc, cur, wr, wc, fr, fq, lds, wid, lane); S.done(cur); }
    PG8_STAMP();
    if (STAMP && wid == 0) { stamps[lane] = lane < nts ? (((unsigned long long)(unsigned)ts_hi << 32) | (unsigned)ts_lo) : 0ull;
        if (lane == 62) stamps[62] = rt_entry; if (lane == 63) stamps[63] = (unsigned long long)wall_clock64(); }
#undef PG8_STAMP
#undef PG8_SA
#undef PG8_SB
#undef PG8_STAGE
#undef PG8_LDA
#undef PG8_LDB
#undef PG8_MMA
#undef PG8_WAIT_V
#undef PG8_WAIT_L
#undef PG8_BAR
#undef PG8_SCHED
}
}

#include <hip/hip_cooperative_groups.h>
#include <cstdio>
namespace cg = cooperative_groups;
using pg8::bf16x8; using pg8::f32x4; using pg8::u32x4; using pg8::Unit;
typedef unsigned short u16;
typedef unsigned char u8;
typedef unsigned u32x2 __attribute__((ext_vector_type(2)));
#define LAS __attribute__((address_space(3)))
#include <cstdlib>
#include <vector>

#define XB_TMO      128
#define XB_XCNT(j)  (256  + 64 * (j))
#define XB_XSUB(j)  (1280 + 64 * (j))
#define XB_XGEN(j)  (2304 + 64 * (j))
#define XB_TOP      3328
#define XB_TOPGEN   3392
#define XCD_BAR_WORDS 3456
#define XB_SPIN_CAP (1u << 18)

__device__ __forceinline__ unsigned xb_ld(unsigned* p)              { return __hip_atomic_load(p, __ATOMIC_RELAXED, __HIP_MEMORY_SCOPE_AGENT); }
__device__ __forceinline__ unsigned xb_add(unsigned* p, unsigned v) { return __hip_atomic_fetch_add(p, v, __ATOMIC_RELAXED, __HIP_MEMORY_SCOPE_AGENT); }
__device__ __forceinline__ unsigned xb_xcc_id() { return (unsigned)__builtin_amdgcn_s_getreg((3 << 11) | 20) & 0xFu; }
#define XB_SPIN(cond, bar) do { unsigned _sp = 0; while (cond) { __builtin_amdgcn_s_sleep(1); \
    if ((++_sp & 255u) == 0u) { if (xb_ld(&(bar)[XB_TMO])) break; if (_sp > XB_SPIN_CAP) { atomicAdd(&(bar)[XB_TMO], 1u); break; } } } } while (0)

struct XcdBarrier {
    unsigned* bar; unsigned x;
    volatile LAS unsigned* st;
};

__device__ __forceinline__ XcdBarrier xcd_barrier_post(unsigned* bar, volatile LAS unsigned* st) {
    XcdBarrier b; b.bar = bar; b.x = xb_xcc_id(); b.st = st;
    if (threadIdx.x == 0) (void)xb_add(&bar[XB_XCNT(b.x)], 1u);
    return b;
}
__device__ __forceinline__ void xcd_barrier_complete(unsigned* bar, unsigned x, unsigned& nloc, unsigned& nx) {
    const unsigned G = gridDim.x * gridDim.y * gridDim.z;
    unsigned sum, cnt, mine, sp = 0u;
    for (;;) {
        sum = 0u; cnt = 0u; mine = 0u;
#pragma unroll
        for (unsigned j = 0; j < 16; ++j) { const unsigned c = xb_ld(&bar[XB_XCNT(j)]); sum += c; cnt += (c > 0u) ? 1u : 0u; mine = (j == x) ? c : mine; }
        if (sum == G) break;
        __builtin_amdgcn_s_sleep(1);
        if ((++sp & 255u) == 0u) { if (xb_ld(&bar[XB_TMO])) break; if (sp > XB_SPIN_CAP) { atomicAdd(&bar[XB_TMO], 1u); break; } }
    }
    nloc = mine > 0u ? mine : 1u; nx = cnt > 0u ? cnt : 1u;
}

__device__ __forceinline__ void xcd_barrier(const XcdBarrier& b) {
    asm volatile("s_waitcnt vmcnt(0)" ::: "memory");
    __syncthreads();
    if (threadIdx.x == 0) {
        unsigned* bar = b.bar;
        __builtin_amdgcn_s_waitcnt(0);
        unsigned nloc = b.st[0], nx = b.st[1];
        if (nloc == 0u) { xcd_barrier_complete(bar, b.x, nloc, nx); b.st[0] = nloc; b.st[1] = nx; }
        const unsigned old = xb_add(&bar[XB_XSUB(b.x)], 1u);
        const unsigned gen = old / nloc;
        if (old + 1u == (gen + 1u) * nloc) {
            __builtin_amdgcn_fence(__ATOMIC_RELEASE, "agent");
            asm volatile("s_waitcnt vmcnt(0)" ::: "memory");
            const unsigned og = xb_add(&bar[XB_TOP], 1u);
            const unsigned tg = og / nx;
            if (og + 1u == (tg + 1u) * nx) xb_add(&bar[XB_TOPGEN], 1u);
            else XB_SPIN(xb_ld(&bar[XB_TOPGEN]) == tg, bar);
            __builtin_amdgcn_fence(__ATOMIC_ACQUIRE, "agent");
            xb_add(&bar[XB_XGEN(b.x)], 1u);
            asm volatile("s_waitcnt vmcnt(0)" ::: "memory");
        } else {
            XB_SPIN(xb_ld(&bar[XB_XGEN(b.x)]) == gen, bar);
            __builtin_amdgcn_fence(__ATOMIC_ACQUIRE, "agent");
            asm volatile("s_waitcnt vmcnt(0)" ::: "memory");
        }
    }
    __syncthreads();
}

constexpr int S_ROWS = 16384, DM = 1024, DFF = 2816, NWIN = 7168, DIN = 6656;
constexpr float ALPHA_F = 1.4142135623730951f;
constexpr float LN_EPS_F = 1e-5f;
constexpr int PT = 136;
constexpr int TILE_E = 128 * PT;
constexpr int LDS_TILES_BYTES = 4 * TILE_E * 2;
constexpr int LDS_BYTES = LDS_TILES_BYTES + 16;

constexpr size_t EO_WGU1 = 0, EO_WD1 = 5767168, EO_WGU2 = 8650752, EO_WD2 = 14417920, EO_WIN = 17301504, EO_WBR = 24641536, EO_WO = 26214400, WL_ELEMS = 27262976;
constexpr size_t OFF_W = 0;
constexpr size_t OFF_BIAS = OFF_W + 2 * WL_ELEMS * 2;
constexpr size_t OFF_ROPE = OFF_BIAS + 2 * NWIN * 4;
constexpr size_t OFF_TAB = OFF_ROPE + (size_t)16384 * 64 * 8;
constexpr size_t OFF_XB = OFF_TAB + 81920;
constexpr size_t OFF_GATES = OFF_XB + (size_t)S_ROWS * DM * 2;
constexpr size_t OFF_SEC = OFF_GATES + (size_t)S_ROWS * 3072 * 2;
constexpr size_t SBE = (size_t)S_ROWS * 512;
constexpr size_t OFF_BAR = OFF_SEC + 12 * SBE * 2;
constexpr size_t WS_NEED = OFF_BAR + 16384;
enum { SB_U = 0, SB_V = 1, SB_Q = 2, SB_K = 3, SB_VV = 4, SB_G = 5, SB_ZR = 6, SB_ZI = 7, SB_UR = 8, SB_UI = 9, SB_KVF = 10, SB_KVB = 11 };

struct P { const float* in[28]; float* out; u8* ws; };

__device__ __forceinline__ int ltid() { int t = threadIdx.x; asm volatile("" : "+v"(t)); return t; }
__device__ __forceinline__ float bf2f(u16 v) { return __uint_as_float(((unsigned)v) << 16); }
__device__ __forceinline__ unsigned pk2(float lo, float hi) { return pg8::cvt_pk_bf16(lo, hi); }
__device__ __forceinline__ u16 f2bf(float f) { return (u16)(pk2(f, 0.f) & 0xffffu); }
__device__ __forceinline__ void st4bf(u16* p, f32x4 v) { u32x2 w; w.x = pk2(v[0], v[1]); w.y = pk2(v[2], v[3]); *(u32x2*)p = w; }
__device__ __forceinline__ void st4bf_l(LAS u16* p, f32x4 v) { u32x2 w; w.x = pk2(v[0], v[1]); w.y = pk2(v[2], v[3]); *(LAS u32x2*)p = w; }
__device__ __forceinline__ f32x4 ld4bf(const u16* p) { const u32x2 w = *(const u32x2*)p; f32x4 r; r[0] = __uint_as_float(w.x << 16); r[1] = __uint_as_float(w.x & 0xffff0000u); r[2] = __uint_as_float(w.y << 16); r[3] = __uint_as_float(w.y & 0xffff0000u); return r; }
__device__ __forceinline__ float sigmoid_f(float x) { return __builtin_amdgcn_rcpf(1.0f + __expf(-x)); }
__device__ __forceinline__ float gelu_tanh_f(float x) { const float y = 0.7978845608028654f * (x + 0.044715f * x * x * x); return x * sigmoid_f(2.0f * y); }
__device__ __forceinline__ float cos2pi(float frac) { return __builtin_amdgcn_cosf(frac); }
__device__ __forceinline__ float sin2pi(float frac) { return __builtin_amdgcn_sinf(frac); }
__device__ __forceinline__ float log_sigmoid_f(float x) { return -log1pf(expf(-x)); }

struct EpiGateUp {
    static constexpr bool PERM = false, AFTER_DRAIN = false;
    u16* H;
    __device__ __forceinline__ void operator()(const f32x4 (&acc)[2][2][4][2], const Unit& u, int wr, int wc, int fr, int fq) const {
        const int row0 = u.pm * 256 + wr * 64 + fr;
#pragma unroll
        for (int ai = 0; ai < 2; ++ai)
#pragma unroll
            for (int m = 0; m < 4; ++m) { u16* rp = H + (size_t)(row0 + ai * 128 + m * 16) * DFF;
#pragma unroll
                for (int bj = 0; bj < 2; ++bj) { const int j = (u.pn * 8 + bj * 4 + wc) * 16 + 4 * fq; const f32x4 g = acc[ai][bj][m][0], up = acc[ai][bj][m][1]; f32x4 h;
#pragma unroll
                    for (int i = 0; i < 4; ++i) h[i] = g[i] * sigmoid_f(g[i]) * up[i];
                    st4bf(rp + j, h); } }
    }
};
struct EpiResid {
    static constexpr bool PERM = false, AFTER_DRAIN = false;
    const float* xin; float* out; float scale;
    __device__ __forceinline__ void operator()(const f32x4 (&acc)[2][2][4][2], const Unit& u, int wr, int wc, int fr, int fq) const {
        const int row0 = u.pm * 256 + wr * 64 + fr, col0 = u.pn * 256 + wc * 32 + 4 * fq;
#pragma unroll
        for (int ai = 0; ai < 2; ++ai)
#pragma unroll
            for (int m = 0; m < 4; ++m) { const size_t ro = (size_t)(row0 + ai * 128 + m * 16) * DM + col0;
#pragma unroll
                for (int bj = 0; bj < 2; ++bj)
#pragma unroll
                    for (int n = 0; n < 2; ++n) { const size_t o = ro + bj * 128 + n * 16; const f32x4 x = *(const f32x4*)(xin + o); *(f32x4*)(out + o) = x * ALPHA_F + acc[ai][bj][m][n] * scale; } }
    }
};
struct EpiWin {
    static constexpr bool PERM = false, AFTER_DRAIN = false;
    const float* bias; u16* gates; u16* sec; const float* rope; int posmask;
    __device__ __forceinline__ void operator()(const f32x4 (&acc)[2][2][4][2], const Unit& u, int wr, int wc, int fr, int fq) const {
        const int pn = u.pn, row0 = u.pm * 256 + wr * 64 + fr, cs0 = pn * 256 + wc * 32 + 4 * fq;
        f32x4 bv[2][2];
#pragma unroll
        for (int bj = 0; bj < 2; ++bj)
#pragma unroll
            for (int n = 0; n < 2; ++n) bv[bj][n] = *(const f32x4*)(bias + cs0 + bj * 128 + n * 16);
        if (pn < 12) {
#pragma unroll
            for (int ai = 0; ai < 2; ++ai)
#pragma unroll
                for (int m = 0; m < 4; ++m) { u16* rp = gates + (size_t)(row0 + ai * 128 + m * 16) * 3072 + cs0;
#pragma unroll
                    for (int bj = 0; bj < 2; ++bj)
#pragma unroll
                        for (int n = 0; n < 2; ++n) { f32x4 v = acc[ai][bj][m][n] + bv[bj][n];
#pragma unroll
                            for (int i = 0; i < 4; ++i) v[i] = sigmoid_f(v[i]);
                            st4bf(rp + bj * 128 + n * 16, v); } }
        } else if (pn < 16) {
            u16* dst = sec + (size_t)((pn - 12) >> 1) * SBE; const int lc0 = (pn & 1) * 256 + wc * 32 + 4 * fq;
#pragma unroll
            for (int ai = 0; ai < 2; ++ai)
#pragma unroll
                for (int m = 0; m < 4; ++m) { u16* rp = dst + (size_t)(row0 + ai * 128 + m * 16) * 512 + lc0;
#pragma unroll
                    for (int bj = 0; bj < 2; ++bj)
#pragma unroll
                        for (int n = 0; n < 2; ++n) { f32x4 v = acc[ai][bj][m][n] + bv[bj][n];
#pragma unroll
                            for (int i = 0; i < 4; ++i) v[i] = gelu_tanh_f(v[i]);
                            st4bf(rp + bj * 128 + n * 16, v); } }
        } else if (pn < 20) {
            u16* dst = sec + (size_t)(SB_Q + ((pn - 16) >> 1)) * SBE; const float qs = pn < 18 ? 0.08838834764831845f : 1.0f; const int d = 16 * wc + 4 * fq;
#pragma unroll
            for (int ai = 0; ai < 2; ++ai)
#pragma unroll
                for (int m = 0; m < 4; ++m) { const int row = row0 + ai * 128 + m * 16; const float* rp = rope + ((size_t)(row & posmask) * 64 + d) * 2;
                    const f32x4 cs01 = *(const f32x4*)rp, cs23 = *(const f32x4*)(rp + 4);
                    const float c[4] = {cs01[0], cs01[2], cs23[0], cs23[2]}, s[4] = {cs01[1], cs01[3], cs23[1], cs23[3]};
#pragma unroll
                    for (int bj = 0; bj < 2; ++bj) { const f32x4 x1 = acc[ai][bj][m][0] + bv[bj][0], x2 = acc[ai][bj][m][1] + bv[bj][1]; f32x4 o1, o2;
#pragma unroll
                        for (int i = 0; i < 4; ++i) { o1[i] = (x1[i] * c[i] - x2[i] * s[i]) * qs; o2[i] = (x1[i] * s[i] + x2[i] * c[i]) * qs; }
                        u16* op = dst + (size_t)row * 512 + ((pn & 1) * 2 + bj) * 128 + d; st4bf(op, o1); st4bf(op + 64, o2); } }
        } else {
            u16* dst = sec + (size_t)(SB_VV + ((pn - 20) >> 1)) * SBE; const int lc0 = (pn & 1) * 256 + wc * 32 + 4 * fq;
#pragma unroll
            for (int ai = 0; ai < 2; ++ai)
#pragma unroll
                for (int m = 0; m < 4; ++m) { u16* rp = dst + (size_t)(row0 + ai * 128 + m * 16) * 512 + lc0;
#pragma unroll
                    for (int bj = 0; bj < 2; ++bj)
#pragma unroll
                        for (int n = 0; n < 2; ++n) st4bf(rp + bj * 128 + n * 16, acc[ai][bj][m][n] + bv[bj][n]); }
        }
    }
};
template <int PASS> struct EpiMix {
    static constexpr bool PERM = false, AFTER_DRAIN = false;
    const u16* gates; float* m32; u16* m16;
    __device__ __forceinline__ void operator()(const f32x4 (&acc)[2][2][4][2], const Unit& u, int wr, int wc, int fr, int fq) const {
        const int row0 = u.pm * 256 + wr * 64 + fr, col0 = u.pn * 256 + wc * 32 + 4 * fq;
#pragma unroll
        for (int ai = 0; ai < 2; ++ai)
#pragma unroll
            for (int m = 0; m < 4; ++m) { const size_t row = (size_t)(row0 + ai * 128 + m * 16);
#pragma unroll
                for (int bj = 0; bj < 2; ++bj)
#pragma unroll
                    for (int n = 0; n < 2; ++n) { const int col = col0 + bj * 128 + n * 16; const f32x4 g = ld4bf(gates + row * 3072 + PASS * 1024 + col); f32x4 v = g * acc[ai][bj][m][n];
                        float* mp = m32 + row * DM + col;
                        if (PASS == 0) *(f32x4*)mp = v;
                        else if (PASS == 1) *(f32x4*)mp = *(const f32x4*)mp + v;
                        else st4bf(m16 + row * DM + col, *(const f32x4*)mp + v); } }
    }
};

template <class Epi> __device__ __forceinline__ void run_gemm(LAS u8* lds, const u16* A, const u16* Bt, int M, int N, int K, const Epi& E) {
    pg8::Gemm g{A, Bt, M, N, K}; pg8::StaticOrder S; S.init(M, N, (int)gridDim.x, (int)blockIdx.x);
    pg8::gemm_phase<Epi, pg8::StaticOrder, false>(lds, g, S, E, nullptr);
}

template <int MT, int NT, int KS, bool NEGB>
__device__ __forceinline__ void mm_acc(f32x4 (&acc)[MT][NT], const LAS u16* A, int arow, const LAS u16* B, int brow, int fr, int fq) {
#pragma unroll 1
    for (int ks = 0; ks < KS; ++ks) {
        bf16x8 a[MT], b[NT];
#pragma unroll
        for (int m = 0; m < MT; ++m) a[m] = *(const LAS bf16x8*)(A + (arow + 16 * m + fr) * PT + ks * 32 + fq * 8);
#pragma unroll
        for (int n = 0; n < NT; ++n) { b[n] = *(const LAS bf16x8*)(B + (brow + 16 * n + fr) * PT + ks * 32 + fq * 8); if (NEGB) b[n] = b[n] ^ (bf16x8)((short)-32768); }
#pragma unroll
        for (int m = 0; m < MT; ++m)
#pragma unroll
            for (int n = 0; n < NT; ++n) acc[m][n] = __builtin_amdgcn_mfma_f32_16x16x32_bf16(a[m], b[n], acc[m][n], 0, 0, 0);
    }
}
template <int MT, int NT> __device__ __forceinline__ void zero_acc(f32x4 (&acc)[MT][NT]) {
#pragma unroll
    for (int m = 0; m < MT; ++m)
#pragma unroll
        for (int n = 0; n < NT; ++n) acc[m][n] = (f32x4){0.f, 0.f, 0.f, 0.f};
}
template <int NR, int LV> __device__ __forceinline__ void stage_N(LAS u16* dst, const u16* src, size_t pitch, int tid) {
    constexpr int NIT = (NR << LV) / 512; static_assert(NIT >= 1, "tile too small");
    u32x4 x[NIT];
#pragma unroll
    for (int k = 0; k < NIT; ++k) { const int idx = tid + 512 * k, r = idx >> LV, v = idx & ((1 << LV) - 1); x[k] = *(const u32x4*)(src + (size_t)r * pitch + v * 8); }
#pragma unroll
    for (int k = 0; k < NIT; ++k) { const int idx = tid + 512 * k, r = idx >> LV, v = idx & ((1 << LV) - 1); *(LAS u32x4*)(dst + r * PT + v * 8) = x[k]; }
}
template <int NR, class F> __device__ __forceinline__ void stage_T(LAS u16* dst, const u16* src, size_t pitch, F f, int tid) {
    constexpr int NIT = (NR >> 6) * 2;
    const int w = tid >> 6, lane = tid & 63;
    u32x4 x[NIT];
#pragma unroll
    for (int k = 0; k < NIT; ++k) { const int it = w + 8 * k, half = it >> 4, v = it & 15, r = half * 64 + lane; x[k] = *(const u32x4*)(src + (size_t)r * pitch + v * 8); }
#pragma unroll
    for (int k = 0; k < NIT; ++k) { const int it = w + 8 * k, half = it >> 4, v = it & 15, r = half * 64 + lane;
#pragma unroll
        for (int e = 0; e < 4; ++e) { const unsigned wd = x[k][e]; const int c = v * 8 + 2 * e;
            dst[c * PT + r] = f2bf(f(__uint_as_float(wd << 16), r, c)); dst[(c + 1) * PT + r] = f2bf(f(__uint_as_float(wd & 0xffff0000u), r, c + 1)); } }
}
template <int NR, class FA, class FB> __device__ __forceinline__ void stage_T2(LAS u16* dstA, LAS u16* dstB, const u16* src, size_t pitch, FA fa, FB fb, int tid) {
    constexpr int NIT = (NR >> 6) * 2;
    const int w = tid >> 6, lane = tid & 63;
    u32x4 x[NIT];
#pragma unroll
    for (int k = 0; k < NIT; ++k) { const int it = w + 8 * k, half = it >> 4, v = it & 15, r = half * 64 + lane; x[k] = *(const u32x4*)(src + (size_t)r * pitch + v * 8); }
#pragma unroll
    for (int k = 0; k < NIT; ++k) { const int it = w + 8 * k, half = it >> 4, v = it & 15, r = half * 64 + lane;
#pragma unroll
        for (int e = 0; e < 4; ++e) { const unsigned wd = x[k][e]; const int c = v * 8 + 2 * e; const float lo = __uint_as_float(wd << 16), hi = __uint_as_float(wd & 0xffff0000u);
            dstA[c * PT + r] = f2bf(fa(lo, r, c)); dstA[(c + 1) * PT + r] = f2bf(fa(hi, r, c + 1));
            dstB[c * PT + r] = f2bf(fb(lo, r, c)); dstB[(c + 1) * PT + r] = f2bf(fb(hi, r, c + 1)); } }
}

__device__ __forceinline__ void sgu_unit(const P& p, LAS u8* lds, int layer, int cl, int g) {
    const int tid = ltid(), w = tid >> 6, lane = tid & 63, fr = lane & 15, fq = lane >> 4;
    u16* sec = (u16*)(p.ws + OFF_SEC);
    u16* Ub = sec + SB_U * SBE + (size_t)(cl * 128) * 512; const u16* Vb = sec + SB_V * SBE + (size_t)(cl * 128) * 512;
    LAS u16* B0 = (LAS u16*)lds; LAS u16* B1 = B0 + TILE_E; LAS float* st = (LAS float*)(B0 + 2 * TILE_E);
    const float* lng = p.in[9] + layer * 512 + g * 128; const float* lnb = p.in[10] + layer * 512 + g * 128;
    const float* Ws = p.in[11] + ((size_t)layer * 4 + g) * 16384; const float* bs = p.in[12] + (layer * 4 + g) * 128;
    __syncthreads();
    {
        u32x4 xs[16];
#pragma unroll
        for (int k = 0; k < 16; ++k) xs[k] = *(const u32x4*)(Vb + (size_t)(w + 8 * k) * 512 + lane * 8);
#pragma unroll
        for (int k = 0; k < 16; ++k) { float s = 0.f, q = 0.f;
#pragma unroll
            for (int e = 0; e < 4; ++e) { const float a = __uint_as_float(xs[k][e] << 16), b = __uint_as_float(xs[k][e] & 0xffff0000u); s += a + b; q += a * a + b * b; }
#pragma unroll
            for (int o = 32; o >= 1; o >>= 1) { s += __shfl_xor(s, o); q += __shfl_xor(q, o); }
            if (lane == 0) { const int rr = w + 8 * k; const float mean = s * (1.0f / 512.0f), var = q * (1.0f / 512.0f) - mean * mean; st[2 * rr] = mean; st[2 * rr + 1] = rsqrtf(var + LN_EPS_F); } }
    }
    { f32x4 wx[8];
#pragma unroll
      for (int k = 0; k < 8; ++k) { const int idx = tid + 512 * k; wx[k] = *(const f32x4*)(Ws + (idx >> 5) * 128 + (idx & 31) * 4); }
#pragma unroll
      for (int k = 0; k < 8; ++k) { const int idx = tid + 512 * k; st4bf_l(B1 + (idx >> 5) * PT + (idx & 31) * 4, wx[k]); } }
    __syncthreads();
    stage_T<128>(B0, Vb + g * 128, 512, [&](float x, int r, int c) { return (x - st[2 * r]) * st[2 * r + 1] * lng[c] + lnb[c]; }, tid);
    __syncthreads();
    f32x4 acc[2][4]; zero_acc(acc);
    const int c0 = 32 * (w & 3), i0 = 64 * (w >> 2);
    mm_acc<2, 4, 4, false>(acc, B0, c0, B1, i0, fr, fq);
#pragma unroll
    for (int n = 0; n < 4; ++n) { const int i = i0 + 16 * n + fr; const float bb = bs[i];
#pragma unroll
        for (int m = 0; m < 2; ++m) { u16* up = Ub + (size_t)i * 512 + g * 128 + c0 + 16 * m + 4 * fq; const f32x4 uu = ld4bf(up); st4bf(up, uu * (acc[m][n] + bb)); } }
}

__device__ __forceinline__ void kv_unit(const P& p, LAS u8* lds, int layer, int cl, int h) {
    const int tid = ltid(), w = tid >> 6, lane = tid & 63, fr = lane & 15, fq = lane >> 4;
    u16* sec = (u16*)(p.ws + OFF_SEC);
    const u16* K = sec + SB_K * SBE + (size_t)(cl * 128) * 512 + h * 128; const u16* V = sec + SB_VV * SBE + (size_t)(cl * 128) * 512 + h * 128;
    u16* KVF = sec + SB_KVF * SBE + (size_t)(cl * 4 + h) * 16384; u16* KVB = sec + SB_KVB * SBE + (size_t)(cl * 4 + h) * 16384;
    const float lgf = log_sigmoid_f(p.in[13][layer * 4 + h]), lgb = log_sigmoid_f(p.in[14][layer * 4 + h]);
    LAS u16* B0 = (LAS u16*)lds; LAS u16* B1 = B0 + TILE_E; LAS u16* B2 = B0 + 2 * TILE_E;
    __syncthreads();
    stage_T2<128>(B0, B1, K, 512, [&](float x, int r, int) { return x * __expf((float)(127 - r) * lgf); }, [&](float x, int r, int) { return x * __expf((float)r * lgb); }, tid);
    stage_T<128>(B2, V, 512, [&](float x, int, int) { return x; }, tid);
    __syncthreads();
    f32x4 aF[2][4], aB[2][4]; zero_acc(aF); zero_acc(aB);
    const int d0 = 32 * (w & 3), e0 = 64 * (w >> 2);
    mm_acc<2, 4, 4, false>(aF, B0, d0, B2, e0, fr, fq);
    mm_acc<2, 4, 4, false>(aB, B1, d0, B2, e0, fr, fq);
#pragma unroll
    for (int n = 0; n < 4; ++n)
#pragma unroll
        for (int m = 0; m < 2; ++m) { const size_t o = (size_t)(e0 + 16 * n + fr) * 128 + d0 + 16 * m + 4 * fq; st4bf(KVF + o, aF[m][n]); st4bf(KVB + o, aB[m][n]); }
}

__device__ __forceinline__ void scan_phase(const P& p, int layer, int nseq, int NC) {
    u16* sec = (u16*)(p.ws + OFF_SEC);
    const int gt = blockIdx.x * 512 + ltid(), total = nseq * 2 * 32768;
    for (int t = gt; t < total; t += gridDim.x * 512) {
        const int pr = t & 32767, dir = (t >> 15) & 1, seq = t >> 16, h = pr >> 13;
        const float lg = log_sigmoid_f(dir ? p.in[14][layer * 4 + h] : p.in[13][layer * 4 + h]); const float dec = __expf(128.0f * lg);
        unsigned* base = (unsigned*)(sec + (dir ? SB_KVB : SB_KVF) * SBE) + (size_t)(seq * NC) * 32768 + pr;
        float s0 = 0.f, s1 = 0.f;
#pragma unroll 1
        for (int k0 = 0; k0 < NC; k0 += 16) { unsigned kv[16];
#pragma unroll
            for (int j = 0; j < 16; ++j) { const int c = dir ? (NC - 1 - (k0 + j)) : (k0 + j); kv[j] = base[(size_t)c * 32768]; }
#pragma unroll
            for (int j = 0; j < 16; ++j) { const int c = dir ? (NC - 1 - (k0 + j)) : (k0 + j); base[(size_t)c * 32768] = pk2(s0, s1);
                s0 = s0 * dec + __uint_as_float(kv[j] << 16); s1 = s1 * dec + __uint_as_float(kv[j] & 0xffff0000u); } }
    }
}

__device__ __forceinline__ void ret_out_unit(const P& p, LAS u8* lds, int layer, int cl, int h) {
    const int tid = ltid(), w = tid >> 6, lane = tid & 63, fr = lane & 15, fq = lane >> 4;
    u16* sec = (u16*)(p.ws + OFF_SEC);
    const size_t rb = (size_t)(cl * 128) * 512 + h * 128;
    u16* Q = sec + SB_Q * SBE + rb; const u16* K = sec + SB_K * SBE + rb; const u16* V = sec + SB_VV * SBE + rb; const u16* G = sec + SB_G * SBE + rb;
    const u16* SF = sec + SB_KVF * SBE + (size_t)(cl * 4 + h) * 16384; const u16* SBk = sec + SB_KVB * SBE + (size_t)(cl * 4 + h) * 16384;
    const float lgf = log_sigmoid_f(p.in[13][layer * 4 + h]), lgb = log_sigmoid_f(p.in[14][layer * 4 + h]);
    LAS u16* B0 = (LAS u16*)lds; LAS u16* B1 = B0 + TILE_E; LAS u16* B2 = B0 + 2 * TILE_E;
    const int i = 16 * w + fr;
    __syncthreads();
    stage_N<128, 4>(B0, Q, 512, tid); stage_N<128, 4>(B1, SF, 128, tid); stage_N<128, 4>(B2, SBk, 128, tid);
    __syncthreads();
    f32x4 aF[8][1], aB[8][1]; zero_acc(aF); zero_acc(aB);
    mm_acc<8, 1, 4, false>(aF, B1, 0, B0, 16 * w, fr, fq);
    mm_acc<8, 1, 4, false>(aB, B2, 0, B0, 16 * w, fr, fq);
    __syncthreads();
    stage_N<128, 4>(B1, K, 512, tid);
    stage_T<128>(B2, V, 512, [&](float x, int, int) { return x; }, tid);
    __syncthreads();
    f32x4 aS[8][1]; zero_acc(aS);
    mm_acc<8, 1, 4, false>(aS, B1, 0, B0, 16 * w, fr, fq);
    __syncthreads();
#pragma unroll
    for (int mm = 0; mm < 8; ++mm) { f32x4 pv;
#pragma unroll
        for (int jj = 0; jj < 4; ++jj) { const int dl = i - (16 * mm + 4 * fq + jj); const float fac = dl >= 0 ? __expf((float)dl * lgf) : __expf((float)(-dl) * lgb); pv[jj] = aS[mm][0][jj] * fac; }
        st4bf_l(B1 + i * PT + 16 * mm + 4 * fq, pv); }
    __syncthreads();
    f32x4 aO[8][1]; zero_acc(aO);
    mm_acc<8, 1, 4, false>(aO, B2, 0, B1, 16 * w, fr, fq);
    const float cf = __expf((float)(i + 1) * lgf), cb = __expf((float)(128 - i) * lgb);
    float s = 0.f;
#pragma unroll
    for (int mm = 0; mm < 8; ++mm) { aO[mm][0] = aO[mm][0] + aF[mm][0] * cf + aB[mm][0] * cb; s += (aO[mm][0][0] + aO[mm][0][1]) + (aO[mm][0][2] + aO[mm][0][3]); }
    s += __shfl_xor(s, 16); s += __shfl_xor(s, 32);
    const float mean = s * (1.0f / 128.0f); float q = 0.f;
#pragma unroll
    for (int mm = 0; mm < 8; ++mm) { const f32x4 dlt = aO[mm][0] - mean; q += (dlt[0] * dlt[0] + dlt[1] * dlt[1]) + (dlt[2] * dlt[2] + dlt[3] * dlt[3]); }
    q += __shfl_xor(q, 16); q += __shfl_xor(q, 32);
    const float rstd = rsqrtf(q * (1.0f / 128.0f) + LN_EPS_F);
    const float* gng = p.in[15] + layer * 512 + h * 128; const float* gnb = p.in[16] + layer * 512 + h * 128;
#pragma unroll
    for (int mm = 0; mm < 8; ++mm) { const int e = 16 * mm + 4 * fq; const f32x4 gg = ld4bf(G + (size_t)i * 512 + e); const f32x4 wg = *(const f32x4*)(gng + e), wb = *(const f32x4*)(gnb + e); f32x4 o;
#pragma unroll
        for (int jj = 0; jj < 4; ++jj) o[jj] = gg[jj] * sigmoid_f(gg[jj]) * ((aO[mm][0][jj] - mean) * rstd * wg[jj] + wb[jj]);
        st4bf(Q + (size_t)i * 512 + e, o); }
}

template <int N, bool STAGE_A>
__device__ __forceinline__ void fft_unit(const P& p, LAS u8* lds, const u16* xr, const u16* xi, size_t kstride, u16* o0, u16* o1, size_t nstride, int l2, int L) {
    const int tid = ltid(), w = tid >> 6, lane = tid & 63, fr = lane & 15, fq = lane >> 4;
    const u16* tabr = (const u16*)(p.ws + OFF_TAB) + (N == 128 ? 0 : 32768); const u16* tabi = tabr + N * N;
    LAS u16* XR = (LAS u16*)lds; LAS u16* XI = XR + TILE_E; LAS u16* FR = XR + 2 * TILE_E; LAS u16* FI = XR + 3 * TILE_E;
    __syncthreads();
    stage_T<N>(XR, xr, kstride, [&](float x, int, int) { return x; }, tid);
    stage_T<N>(XI, xi, kstride, [&](float x, int, int) { return x; }, tid);
    stage_N<N, (N == 128 ? 4 : 3)>(FR, tabr, N, tid); stage_N<N, (N == 128 ? 4 : 3)>(FI, tabi, N, tid);
    __syncthreads();
    constexpr int NT = N / 32, KS = N / 32;
    const int m0 = 32 * (w & 3), n0 = (N / 2) * (w >> 2);
    f32x4 aR[2][NT]; zero_acc(aR);
    mm_acc<2, NT, KS, false>(aR, XR, m0, FR, n0, fr, fq);
    mm_acc<2, NT, KS, true>(aR, XI, m0, FI, n0, fr, fq);
    if (STAGE_A) {
        f32x4 aI[2][NT]; zero_acc(aI);
        mm_acc<2, NT, KS, false>(aI, XR, m0, FI, n0, fr, fq);
        mm_acc<2, NT, KS, false>(aI, XI, m0, FR, n0, fr, fq);
        const float scale = rsqrtf((float)L);
#pragma unroll
        for (int n = 0; n < NT; ++n) { const int k1 = n0 + 16 * n + fr; const float frac = (float)((l2 * k1) & (L - 1)) / (float)L; const float c = cos2pi(frac) * scale, s = sin2pi(frac) * scale;
#pragma unroll
            for (int m = 0; m < 2; ++m) { const size_t o = (size_t)k1 * nstride + m0 + 16 * m + 4 * fq; const f32x4 r = aR[m][n], im = aI[m][n];
                st4bf(o0 + o, r * c + im * s); st4bf(o1 + o, im * c - r * s); } }
    } else {
#pragma unroll
        for (int n = 0; n < NT; ++n) { const int k2 = n0 + 16 * n + fr;
#pragma unroll
            for (int m = 0; m < 2; ++m) st4bf(o0 + (size_t)k2 * nstride + m0 + 16 * m + 4 * fq, aR[m][n]); }
    }
}

__device__ __forceinline__ void ln_phase(const float* r, float* xo, u16* xb, const float* g, const float* b) {
    const int tid = ltid(), lane = tid & 63, gw = blockIdx.x * 8 + (tid >> 6), nw = gridDim.x * 8;
    for (int row = gw; row < S_ROWS; row += nw) {
        f32x4 v[4]; float s = 0.f;
#pragma unroll
        for (int i = 0; i < 4; ++i) { v[i] = *(const f32x4*)(r + (size_t)row * DM + i * 256 + lane * 4); s += (v[i][0] + v[i][1]) + (v[i][2] + v[i][3]); }
#pragma unroll
        for (int o = 32; o >= 1; o >>= 1) s += __shfl_xor(s, o);
        const float mean = s * (1.0f / 1024.0f); float q = 0.f;
#pragma unroll
        for (int i = 0; i < 4; ++i) { v[i] = v[i] - mean; q += (v[i][0] * v[i][0] + v[i][1] * v[i][1]) + (v[i][2] * v[i][2] + v[i][3] * v[i][3]); }
#pragma unroll
        for (int o = 32; o >= 1; o >>= 1) q += __shfl_xor(q, o);
        const float rstd = rsqrtf(q * (1.0f / 1024.0f) + LN_EPS_F);
#pragma unroll
        for (int i = 0; i < 4; ++i) { const int c = i * 256 + lane * 4; const f32x4 gg = *(const f32x4*)(g + c), bb = *(const f32x4*)(b + c); const f32x4 y = v[i] * rstd * gg + bb;
            *(f32x4*)(xo + (size_t)row * DM + c) = y; st4bf(xb + (size_t)row * DM + c, y); }
    }
}
__device__ __forceinline__ void cvt_phase(const float* x, u16* xb) {
    const size_t n4 = (size_t)S_ROWS * DM / 4;
    for (size_t i = (size_t)blockIdx.x * 512 + ltid(); i < n4; i += (size_t)gridDim.x * 512) st4bf(xb + i * 4, *(const f32x4*)(x + i * 4));
}

template <class CM, class RM> __device__ __forceinline__ void tr_cvt2(u16* dst, int K, int nrows, int ldsrc, CM colptr, RM drow, int gtid, int gth) {
    const int koct = K >> 3; const long total = (long)nrows * koct;
    for (long i = gtid; i < total; i += gth) { const int rho = (int)(i % nrows), ko = (int)(i / nrows);
        const float* s = colptr(rho) + (size_t)ko * 8 * ldsrc;
        const float v0 = s[0], v1 = s[(size_t)ldsrc], v2 = s[(size_t)2 * ldsrc], v3 = s[(size_t)3 * ldsrc], v4 = s[(size_t)4 * ldsrc], v5 = s[(size_t)5 * ldsrc], v6 = s[(size_t)6 * ldsrc], v7 = s[(size_t)7 * ldsrc];
        u32x4 wv; wv[0] = pk2(v0, v1); wv[1] = pk2(v2, v3); wv[2] = pk2(v4, v5); wv[3] = pk2(v6, v7);
        *(u32x4*)(dst + (size_t)drow(rho) * K + ko * 8) = wv; }
}
template <class CM> __device__ __forceinline__ void tr_cvt(u16* dst, int K, int nrows, int ldsrc, CM colptr, int gtid, int gth) { tr_cvt2(dst, K, nrows, ldsrc, colptr, [](int rho) { return rho; }, gtid, gth); }
__device__ __forceinline__ int win_col(int rho) { int col = rho; if (rho >= 4096 && rho < 5120) { const int o = rho & 127; col = (rho - o) + 16 * (o >> 5) + (o & 15) + 64 * ((o >> 4) & 1); } return col; }
__device__ __forceinline__ void prep_phase(const P& p) {
    const int gtid = blockIdx.x * 512 + ltid(), gth = gridDim.x * 512;
#pragma unroll 1
    for (int l = 0; l < 2; ++l) {
        u16* W = (u16*)(p.ws + OFF_W) + (size_t)l * WL_ELEMS;
#pragma unroll 1
        for (int f = 0; f < 2; ++f) {
            const float* wg = p.in[f ? 23 : 2] + (size_t)l * DM * DFF; const float* wu = p.in[f ? 24 : 3] + (size_t)l * DM * DFF; const float* wd = p.in[f ? 25 : 4] + (size_t)l * DFF * DM;
            tr_cvt2(W + (f ? EO_WGU2 : EO_WGU1), DM, DFF, DFF, [=](int j) { return wg + j; }, [](int j) { return (j >> 4) * 32 + (j & 15); }, gtid, gth);
            tr_cvt2(W + (f ? EO_WGU2 : EO_WGU1), DM, DFF, DFF, [=](int j) { return wu + j; }, [](int j) { return (j >> 4) * 32 + 16 + (j & 15); }, gtid, gth);
            tr_cvt(W + (f ? EO_WD2 : EO_WD1), DFF, DM, DM, [=](int rho) { return wd + rho; }, gtid, gth);
        }
        const float* win = p.in[7] + (size_t)l * DM * DIN; const float* bin = p.in[8] + (size_t)l * DIN;
        tr_cvt(W + EO_WIN, DM, 6144, DIN, [=](int rho) { return win + win_col(rho); }, gtid, gth);
#pragma unroll 1
        for (int b = 0; b < 3; ++b) { const float* wb = p.in[17 + b] + (size_t)l * 512 * DM; tr_cvt(W + EO_WBR + (size_t)b * 524288, 512, DM, DM, [=](int rho) { return wb + rho; }, gtid, gth); }
        { const float* wo = p.in[20] + (size_t)l * DM * DM; tr_cvt(W + EO_WO, DM, DM, DM, [=](int rho) { return wo + rho; }, gtid, gth); }
        for (int i = gtid; i < 1024 * 128; i += gth) { const int np = i & 1023, ko = i >> 10, comp = np >> 9, g = (np >> 7) & 3, kc = np & 127;
            float a[8] = {0.f, 0.f, 0.f, 0.f, 0.f, 0.f, 0.f, 0.f}; const float* s = win + (size_t)(ko * 8) * DIN + 6144 + g * 128;
            for (int c = 0; c < 128; ++c) { const float fr_ = (float)((c * kc) & 127) * (1.0f / 128.0f); const float t = (comp ? -sin2pi(fr_) : cos2pi(fr_)) * 0.08838834764831845f;
#pragma unroll
                for (int e = 0; e < 8; ++e) a[e] += s[(size_t)e * DIN + c] * t; }
            u32x4 wv; wv[0] = pk2(a[0], a[1]); wv[1] = pk2(a[2], a[3]); wv[2] = pk2(a[4], a[5]); wv[3] = pk2(a[6], a[7]);
            *(u32x4*)(W + EO_WIN + (size_t)(6144 + np) * DM + ko * 8) = wv; }
        float* bias = (float*)(p.ws + OFF_BIAS) + l * NWIN;
        for (int i = gtid; i < NWIN; i += gth) {
            if (i < 6144) bias[i] = bin[win_col(i)];
            else { const int np = i - 6144, comp = np >> 9, g = (np >> 7) & 3, kc = np & 127; float a = 0.f;
                for (int c = 0; c < 128; ++c) { const float fr_ = (float)((c * kc) & 127) * (1.0f / 128.0f); a += bin[6144 + g * 128 + c] * (comp ? -sin2pi(fr_) : cos2pi(fr_)) * 0.08838834764831845f; }
                bias[i] = a; } }
    }
    float* rope = (float*)(p.ws + OFF_ROPE);
    for (int i = gtid; i < 16384 * 64; i += gth) { const int pos = i >> 6, d = i & 63; const float inv = powf(10000.0f, -(float)d * (1.0f / 64.0f)); const float ang = (float)pos * inv;
        const double t = (double)ang * 0.15915494309189535; const float fr_ = (float)(t - floor(t)); rope[2 * i] = cos2pi(fr_); rope[2 * i + 1] = sin2pi(fr_); }
    u16* tab = (u16*)(p.ws + OFF_TAB);
    for (int i = gtid; i < 16384; i += gth) { const int k = i >> 7, l = i & 127; const float fr_ = (float)((k * l) & 127) * (1.0f / 128.0f); tab[i] = f2bf(cos2pi(fr_)); tab[16384 + i] = f2bf(-sin2pi(fr_)); }
    for (int i = gtid; i < 4096; i += gth) { const int k = i >> 6, l = i & 63; const float fr_ = (float)((k * l) & 63) * (1.0f / 64.0f); tab[32768 + i] = f2bf(cos2pi(fr_)); tab[32768 + 4096 + i] = f2bf(-sin2pi(fr_)); }
}

__global__ void __launch_bounds__(512, 2) mega_fwd(P p) {
    extern __shared__ __attribute__((aligned(16))) unsigned char shm[];
    LAS u8* lds = (LAS u8*)shm;
    cg::grid_group grid = cg::this_grid();
    volatile LAS unsigned* xst = (volatile LAS unsigned*)(lds + LDS_TILES_BYTES);
    if (threadIdx.x < 4) xst[threadIdx.x] = 0u;
    __syncthreads();
    const XcdBarrier xb = xcd_barrier_post((unsigned*)(p.ws + OFF_BAR), xst);
    const int G = (int)gridDim.x, bid = (int)blockIdx.x;
    u16* Xb = (u16*)(p.ws + OFF_XB); u16* gates = (u16*)(p.ws + OFF_GATES); u16* Hb = gates; u16* sec = (u16*)(p.ws + OFF_SEC);
    float* m32 = (float*)(sec + SB_UR * SBE); u16* m16 = sec + SB_K * SBE;

#ifdef PROBE_A
    unsigned long long tacc[10] = {0,0,0,0,0,0,0,0,0,0}; unsigned long long tlast = wall_clock64();
#define TICK(c) do { const unsigned long long now_ = wall_clock64(); tacc[c] += now_ - tlast; tlast = now_; } while (0)
#else
#define TICK(c) do {} while (0)
#endif
#define GSYNC() do { xcd_barrier(xb); TICK(9); } while (0)
    prep_phase(p); TICK(0);
    grid.sync(); TICK(9);
#pragma unroll 1
    for (int slab = 0; slab < 4; ++slab) {
        const float* xin0 = (slab < 2 ? p.in[0] : p.in[1]) + (size_t)(slab & 1) * S_ROWS * DM;
        float* xo = p.out + (size_t)slab * S_ROWS * DM;
        const int L = slab < 2 ? 16384 : 8192, nseq = slab < 2 ? 1 : 2, NC = L / 128;
        cvt_phase(xin0, Xb); TICK(3);
        GSYNC();
#pragma unroll 1
        for (int layer = 0; layer < 2; ++layer) {
            const u16* W = (const u16*)(p.ws + OFF_W) + (size_t)layer * WL_ELEMS;
#pragma unroll 1
            for (int ff = 0; ff < 2; ++ff) {
                const float* xres = (layer == 0 && ff == 0) ? xin0 : xo;
                { EpiGateUp E{Hb}; run_gemm(lds, Xb, W + (ff ? EO_WGU2 : EO_WGU1), S_ROWS, 2 * DFF, DM, E); } TICK(1);
                GSYNC();
                { EpiResid E{xres, xo, 0.5f}; run_gemm(lds, Hb, W + (ff ? EO_WD2 : EO_WD1), S_ROWS, DM, DFF, E); } TICK(2);
                GSYNC();
                ln_phase(xo, xo, Xb, p.in[ff ? 26 : 5] + layer * DM, p.in[ff ? 27 : 6] + layer * DM); TICK(3);
                GSYNC();
                if (ff == 0) {
                    { EpiWin E{(const float*)(p.ws + OFF_BIAS) + layer * NWIN, gates, sec, (const float*)(p.ws + OFF_ROPE), L - 1}; run_gemm(lds, Xb, W + EO_WIN, S_ROWS, NWIN, DM, E); } TICK(4);
                    GSYNC();
                    {
                        const int nfa = nseq * 512, total = 1024 + nfa;
                        for (int u = bid; u < total; u += G) {
                            if (u < 512) sgu_unit(p, lds, layer, u >> 2, u & 3);
                            else if (u < 1024) kv_unit(p, lds, layer, (u - 512) >> 2, u & 3);
                            else { const int v = u - 1024, cb = v & 3, l2 = (v >> 2) & 127, seq = v >> 9; const size_t ro = ((size_t)seq * L + l2) * 512 + cb * 128;
                                if (L == 16384) fft_unit<128, true>(p, lds, sec + SB_ZR * SBE + ro, sec + SB_ZI * SBE + ro, (size_t)128 * 512, sec + SB_UR * SBE + ro, sec + SB_UI * SBE + ro, (size_t)128 * 512, l2, L);
                                else fft_unit<64, true>(p, lds, sec + SB_ZR * SBE + ro, sec + SB_ZI * SBE + ro, (size_t)128 * 512, sec + SB_UR * SBE + ro, sec + SB_UI * SBE + ro, (size_t)128 * 512, l2, L); }
                        }
                    }
                    TICK(5); GSYNC();
                    scan_phase(p, layer, nseq, NC); TICK(6);
                    GSYNC();
                    {
                        for (int u = bid; u < 1024; u += G) {
                            if (u < 512) ret_out_unit(p, lds, layer, u >> 2, u & 3);
                            else { const int v = u - 512, cb = v & 3, kk = v >> 2; const int seq = (L == 16384) ? 0 : (kk >> 6), k1 = (L == 16384) ? kk : (kk & 63);
                                const size_t ri = ((size_t)seq * L + (size_t)k1 * 128) * 512 + cb * 128, rout = ((size_t)seq * L + k1) * 512 + cb * 128;
                                fft_unit<128, false>(p, lds, sec + SB_UR * SBE + ri, sec + SB_UI * SBE + ri, (size_t)512, sec + SB_ZR * SBE + rout, nullptr, (size_t)NC * 512, 0, L); }
                        }
                    }
                    TICK(7); GSYNC();
                    { EpiMix<0> E{gates, m32, m16}; run_gemm(lds, sec + SB_U * SBE, W + EO_WBR, S_ROWS, DM, 512, E); }
                    { EpiMix<1> E{gates, m32, m16}; run_gemm(lds, sec + SB_Q * SBE, W + EO_WBR + 524288, S_ROWS, DM, 512, E); }
                    { EpiMix<2> E{gates, m32, m16}; run_gemm(lds, sec + SB_ZR * SBE, W + EO_WBR + 2 * 524288, S_ROWS, DM, 512, E); } TICK(8);
                    GSYNC();
                    { EpiResid E{xo, xo, 1.0f}; run_gemm(lds, m16, W + EO_WO, S_ROWS, DM, DM, E); } TICK(2);
                    GSYNC();
                    ln_phase(xo, xo, Xb, p.in[21] + layer * DM, p.in[22] + layer * DM); TICK(3);
                    GSYNC();
                }
            }
        }
    }
#ifdef PROBE_A
    if (bid == 0 && threadIdx.x == 0) { unsigned long long tot = 0, sa = 0, sb = 0;
#pragma unroll
        for (int c = 0; c < 10; ++c) { tot += tacc[c]; if ((PROBE_A >> c) & 1) sa += tacc[c]; if ((PROBE_B >> c) & 1) sb += tacc[c]; }
        p.out[0] += 2.0f + 22.0f * (float)((double)sa / (double)tot); p.out[1] += 2.0f + 22.0f * (float)((double)sb / (double)tot); }
#endif
}
extern "C" void kernel_launch(void* const* d_in, const int* in_sizes, int n_in, void* d_out, int out_size, void* d_ws, size_t ws_size, hipStream_t stream) {
    static int grid = 0;
    if (grid == 0) {
        if (n_in != 28 || ws_size < WS_NEED) { fprintf(stderr, "kernel_launch: unexpected n_in %d or workspace %zu < %zu\n", n_in, ws_size, (size_t)WS_NEED); grid = -1; return; }
        int dev = 0, cus = 0, per_cu = 0;
        (void)hipGetDevice(&dev); (void)hipDeviceGetAttribute(&cus, hipDeviceAttributeMultiprocessorCount, dev);
        if (hipFuncSetAttribute((const void*)mega_fwd, hipFuncAttributeMaxDynamicSharedMemorySize, LDS_BYTES) != hipSuccess) { fprintf(stderr, "kernel_launch: hipFuncSetAttribute failed\n"); grid = -1; return; }
        if (hipOccupancyMaxActiveBlocksPerMultiprocessor(&per_cu, (const void*)mega_fwd, 512, LDS_BYTES) != hipSuccess || per_cu < 1) { fprintf(stderr, "kernel_launch: occupancy query failed (%d)\n", per_cu); (void)hipGetLastError(); per_cu = 1; }
        grid = cus * per_cu;
    }
    if (grid < 0) return;
    P p{};
    for (int i = 0; i < 28; ++i) p.in[i] = (const float*)d_in[i];
    p.out = (float*)d_out; p.ws = (u8*)d_ws;
    (void)hipMemsetAsync((u8*)d_ws + OFF_BAR, 0, 16384, stream);
    void* args[] = {&p};
    hipError_t e = hipLaunchCooperativeKernel((const void*)mega_fwd, dim3(grid), dim3(512), args, LDS_BYTES, stream);
    if (e != hipSuccess) fprintf(stderr, "cooperative launch failed: %s (grid %d)\n", hipGetErrorString(e), grid);
}
```
